# Optimizing an MI355X kernel written in HIP

```python
import math
import jax, jax.numpy as jnp
from jax import lax
import numpy as np

D_MODEL = 1024
BATCH = 8
SEQ = 4096
DEPTH = 4

EXPAND = 2
BRANCH = EXPAND * D_MODEL
N_HEADS = 16
QK_HALF = 64
V_DIM = 2 * QK_HALF
QK_WIDTH = N_HEADS * 2 * QK_HALF
N_MIXERS = 2
CHUNK = 128
SGU_GROUPS = 16
SGU_GROUP_DIM = BRANCH // SGU_GROUPS
N_BUCKETS = 32
MAX_DISTANCE = 128
Q_BLOCK = 128
EPS = 1e-6
N_ATTN = (DEPTH + 1) // 2
N_SGU = DEPTH // 2

kernel_name = "hybrid_diffattn_chunked_sgu"


def rms_norm(x, g):
    xf = x.astype(jnp.float32)
    y = xf * lax.rsqrt(jnp.mean(xf * xf, axis=-1, keepdims=True) + EPS)
    return (y * g.astype(jnp.float32)).astype(x.dtype)


def t5_bucket(rel):
    n = jnp.maximum(-rel, 0)
    max_exact = N_BUCKETS // 2
    nf = jnp.maximum(n, 1).astype(jnp.float32)
    large = max_exact + (jnp.log(nf / max_exact) / math.log(MAX_DISTANCE / max_exact)
                         * (N_BUCKETS - max_exact)).astype(jnp.int32)
    large = jnp.minimum(large, N_BUCKETS - 1)
    return jnp.where(n < max_exact, n, large)


def diff_attention_branch(h, w_in, lq1, lk1, lq2, lk2, subln_g, rel_bias, lam_init):
    B, S, _ = h.shape
    proj = h @ w_in
    q = proj[..., :QK_WIDTH].reshape(B, S, N_HEADS, 2, QK_HALF)
    k = proj[..., QK_WIDTH:2 * QK_WIDTH].reshape(B, S, N_HEADS, 2, QK_HALF)
    v = proj[..., 2 * QK_WIDTH:2 * QK_WIDTH + BRANCH].reshape(B, S, N_HEADS, V_DIM)
    gate = proj[..., 2 * QK_WIDTH + BRANCH:]
    lam = (jnp.exp(jnp.sum(lq1.astype(jnp.float32) * lk1.astype(jnp.float32)))
           - jnp.exp(jnp.sum(lq2.astype(jnp.float32) * lk2.astype(jnp.float32))) + lam_init)
    q = q.transpose(3, 0, 2, 1, 4)
    k = k.transpose(3, 0, 2, 1, 4)
    v = v.transpose(0, 2, 1, 3)
    k1, k2 = k[0], k[1]
    nb = S // Q_BLOCK
    qb = q.reshape(2, B, N_HEADS, nb, Q_BLOCK, QK_HALF).transpose(3, 0, 1, 2, 4, 5)
    k_pos = jnp.arange(S, dtype=jnp.int32)
    scale = QK_HALF ** -0.5
    table = rel_bias.astype(jnp.float32)

    def block(args):
        i, q_i = args
        q_pos = i * Q_BLOCK + jnp.arange(Q_BLOCK, dtype=jnp.int32)
        rel = k_pos[None, :] - q_pos[:, None]
        bias = table[t5_bucket(rel)].transpose(2, 0, 1)
        causal = rel <= 0

        def probs(qq, kk):
            s = jnp.einsum('bhqd,bhkd->bhqk', qq, kk).astype(jnp.float32) * scale + bias
            s = jnp.where(causal, s, -jnp.inf)
            return jax.nn.softmax(s, axis=-1)

        a = probs(q_i[0], k1) - lam * probs(q_i[1], k2)
        return jnp.einsum('bhqk,bhkd->bhqd', a.astype(v.dtype), v)

    o = lax.map(block, (jnp.arange(nb, dtype=jnp.int32), qb))
    o = o.transpose(1, 0, 3, 2, 4).reshape(B, S, N_HEADS, V_DIM)
    o = rms_norm(o, subln_g) * (1.0 - lam_init)
    o = o.reshape(B, S, BRANCH)
    return o * jax.nn.silu(gate)


def spatial_gating_branch(h, w_in, v_gain, w_s, b_s):
    B, S, _ = h.shape
    proj = h @ w_in
    u = proj[..., :BRANCH]
    v = rms_norm(proj[..., BRANCH:2 * BRANCH], v_gain)
    gate = proj[..., 2 * BRANCH:]
    v = v.reshape(B, S // CHUNK, CHUNK, SGU_GROUPS, SGU_GROUP_DIM)
    causal = jnp.tril(jnp.ones((CHUNK, CHUNK), dtype=bool))
    w = jnp.where(causal[None], w_s, jnp.zeros((), w_s.dtype))
    y = jnp.einsum('gts,bcsgd->bctgd', w, v) + b_s.T[:, :, None]
    y = y.reshape(B, S, BRANCH)
    return u * y * jax.nn.silu(gate)


def setup_inputs(seed: int = 0) -> dict:
    key = jax.random.key(seed)
    ks = jax.random.split(key, 17)
    f32 = jnp.float32
    n = lambda k, shape, s: jax.random.normal(k, shape, f32) * s
    return {
        "x": n(ks[0], (BATCH, SEQ, D_MODEL), 1.0),
        "rel_bias": n(ks[1], (N_BUCKETS, N_HEADS), 0.5),
        "attn_norm": 1.0 + n(ks[2], (N_ATTN, D_MODEL), 0.02),
        "attn_w_in": n(ks[3], (N_ATTN, D_MODEL, 2 * QK_WIDTH + 2 * BRANCH), D_MODEL ** -0.5),
        "attn_lam_q1": n(ks[4], (N_ATTN, QK_HALF), 0.1),
        "attn_lam_k1": n(ks[5], (N_ATTN, QK_HALF), 0.1),
        "attn_lam_q2": n(ks[6], (N_ATTN, QK_HALF), 0.1),
        "attn_lam_k2": n(ks[7], (N_ATTN, QK_HALF), 0.1),
        "attn_subln": 1.0 + n(ks[8], (N_ATTN, V_DIM), 0.02),
        "attn_w_out": n(ks[9], (N_ATTN, BRANCH, D_MODEL), BRANCH ** -0.5),
        "sgu_norm": 1.0 + n(ks[10], (N_SGU, D_MODEL), 0.02),
        "sgu_w_in": n(ks[11], (N_SGU, D_MODEL, 3 * BRANCH), D_MODEL ** -0.5),
        "sgu_v_norm": 1.0 + n(ks[12], (N_SGU, BRANCH), 0.02),
        "sgu_w_s": n(ks[13], (N_SGU, SGU_GROUPS, CHUNK, CHUNK), CHUNK ** -0.5),
        "sgu_b_s": 1.0 + n(ks[14], (N_SGU, SGU_GROUPS, CHUNK), 0.02),
        "sgu_w_out": n(ks[15], (N_SGU, BRANCH, D_MODEL), BRANCH ** -0.5),
        "final_norm": 1.0 + n(ks[16], (D_MODEL,), 0.02),
    }


def reference(x, rel_bias, attn_norm, attn_w_in, attn_lam_q1, attn_lam_k1, attn_lam_q2,
              attn_lam_k2, attn_subln, attn_w_out, sgu_norm, sgu_w_in, sgu_v_norm, sgu_w_s,
              sgu_b_s, sgu_w_out, final_norm):
    for i in range(DEPTH):
        j = i // N_MIXERS
        if i % N_MIXERS == 0:
            lam_init = 0.8 - 0.6 * math.exp(-0.3 * i)
            h = rms_norm(x, attn_norm[j])
            y = diff_attention_branch(h, attn_w_in[j], attn_lam_q1[j], attn_lam_k1[j],
                                      attn_lam_q2[j], attn_lam_k2[j], attn_subln[j],
                                      rel_bias, lam_init)
            x = x + y @ attn_w_out[j]
        else:
            h = rms_norm(x, sgu_norm[j])
            y = spatial_gating_branch(h, sgu_w_in[j], sgu_v_norm[j], sgu_w_s[j], sgu_b_s[j])
            x = x + y @ sgu_w_out[j]
    return rms_norm(x, final_norm)
```

```cpp
#include <hip/hip_runtime.h>
#include <hip/hip_cooperative_groups.h>
#include <cstdio>
#include <cstdint>
namespace cg = cooperative_groups;
#ifndef ONE_LAUNCH
#define ONE_LAUNCH 1
#endif
#ifndef PROBE_DUP
#define PROBE_DUP 0
#endif
#ifndef PROBE_ABL
#define PROBE_ABL 0
#endif
__device__ __forceinline__ int my_tid(int wave_s) { int l; asm volatile("v_mbcnt_lo_u32_b32 %0, -1, 0\n\tv_mbcnt_hi_u32_b32 %0, -1, %0" : "=v"(l)); return wave_s * 64 + l; }
namespace pg8 {
#define PG8_LAS __attribute__((address_space(3)))
typedef unsigned short bf16_t;
typedef short bf16x8 __attribute__((ext_vector_type(8)));
typedef float f32x4 __attribute__((ext_vector_type(4)));
typedef unsigned u32x4 __attribute__((ext_vector_type(4)));
constexpr int BM = 256, BK = 64, HALF = 128, HTB = HALF * BK * 2  , STAGE_BYTES = 8 * HTB, NXCD = 8, WGM = 8;

__host__ __device__ __forceinline__ int lds_byte(int r, int c) { const int st = (r >> 4) * 2 + (c >> 5), rr = r & 15, cc = c & 31, ob = rr * 64 + cc * 2; return st * 1024 + (ob ^ (((ob >> 9) & 1) << 5)); }
__host__ __device__ __forceinline__ void stage_rc(int b, int& R, int& C) { const int st = b / 1024, sb = b % 1024, swz = sb ^ (((sb >> 9) & 1) << 5); R = (st >> 1) * 16 + swz / 64; C = (st & 1) * 32 + (swz % 64) / 2; }
__host__ __device__ __forceinline__ int perm32(int rho) { const int n = rho >> 4, i = rho & 15; return 8 * (i >> 2) + 4 * n + (i & 3); }

struct Unit { int pm, pn; };
struct Gemm { const bf16_t* A; const bf16_t* Bt; int M, N, K; };

struct StaticOrder {
    int nM, nN, nwg, G, c;
    __host__ __device__ void init(int M, int N, int G_, int c_) { nM = M / BM; nN = N / BM; nwg = nM * nN; G = G_; c = c_; }
    __host__ __device__ bool next(int i, Unit& u) const {
        const long L = (long)i * G + c; if (L >= nwg) return false;
        int wgid = (int)L; { const int q = nwg / NXCD, r = nwg % NXCD, xcd = wgid % NXCD, off = wgid / NXCD; wgid = (xcd < r ? xcd * (q + 1) : r * (q + 1) + (xcd - r) * q) + off; }
        const int nig = WGM * nN, gid = wgid / nig, fm = gid * WGM, gsz = (nM - fm) < WGM ? (nM - fm) : WGM;
        u.pm = fm + ((wgid % nig) % gsz); u.pn = (wgid % nig) / gsz; return true;
    }
    __device__ __forceinline__ void a_ready(const Unit&) const {}
    __device__ __forceinline__ void done(const Unit&) const {}
};

__device__ __forceinline__ unsigned cvt_pk_bf16(float lo, float hi) { unsigned r; asm volatile("v_cvt_pk_bf16_f32 %0, %1, %2" : "=v"(r) : "v"(lo), "v"(hi)); return r; }
typedef float f32x2 __attribute__((ext_vector_type(2)));
typedef unsigned u32x2 __attribute__((ext_vector_type(2)));
__device__ __forceinline__ float rstd16(const float* p) {
    const f32x4 a = *(const f32x4*)p, b = *(const f32x4*)(p + 4), c = *(const f32x4*)(p + 8), d = *(const f32x4*)(p + 12);
    const float s = (((a[0] + a[1]) + (a[2] + a[3])) + ((b[0] + b[1]) + (b[2] + b[3]))) + (((c[0] + c[1]) + (c[2] + c[3])) + ((d[0] + d[1]) + (d[2] + d[3])));
    return 1.0f / sqrtf(s * (1.0f / 1024.0f) + 1e-6f);
}
struct EpiIn {
    static constexpr bool PERM = true, AFTER_DRAIN = false;
    bf16_t* O; int ldc; int split_cols; size_t split_stride; float qscale; int q_tiles; const float* rowss; float* vss; int v_lo, v_hi; int ug_tiles;
    __device__ __forceinline__ void operator()(const f32x4 (&acc)[2][2][4][2], const Unit& u, int wr, int wc, int fr, int fq) const {
        const int row0 = u.pm * BM + wr * 64 + fr; int colt = u.pn * BM; bf16_t* base = O;
        if (ug_tiles) {
            if (u.pn < ug_tiles) {
                const int colg = u.pn * HALF + wc * 32 + 8 * fq;
#pragma unroll
                for (int ai = 0; ai < 2; ++ai)
#pragma unroll
                    for (int m = 0; m < 4; ++m) { const int row = row0 + ai * HALF + m * 16; const float sc = rowss[row];
                        const f32x4 u0 = acc[ai][0][m][0] * sc, u1 = acc[ai][0][m][1] * sc, g0 = acc[ai][1][m][0] * sc, g1 = acc[ai][1][m][1] * sc; f32x4 r0, r1;
#pragma unroll
                        for (int e_ = 0; e_ < 4; ++e_) { r0[e_] = u0[e_] * g0[e_] * __builtin_amdgcn_rcpf(1.0f + __builtin_amdgcn_exp2f(-1.4426950408889634f * g0[e_])); r1[e_] = u1[e_] * g1[e_] * __builtin_amdgcn_rcpf(1.0f + __builtin_amdgcn_exp2f(-1.4426950408889634f * g1[e_])); }
                        u32x4 w; w.x = cvt_pk_bf16(r0[0], r0[1]); w.y = cvt_pk_bf16(r0[2], r0[3]); w.z = cvt_pk_bf16(r1[0], r1[1]); w.w = cvt_pk_bf16(r1[2], r1[3]);
                        *(u32x4*)(O + (size_t)row * ldc + colg) = w; }
                return;
            }
            base += split_stride; colt = (u.pn - ug_tiles) * BM;
        } else { const int t = colt / split_cols; base += (size_t)t * split_stride; colt -= t * split_cols; }
        const float qs = (u.pn < q_tiles) ? qscale : 1.f;
        const int col0 = colt + wc * 32 + 8 * fq;
        const bool dov = (u.pn >= v_lo && u.pn < v_hi);
#pragma unroll
        for (int ai = 0; ai < 2; ++ai)
#pragma unroll
            for (int m = 0; m < 4; ++m) {
                const int row = row0 + ai * HALF + m * 16; const float sc = rowss[row] * qs; bf16_t* rowp = base + (size_t)row * ldc + col0; float ss = 0.f;
#pragma unroll
                for (int bj = 0; bj < 2; ++bj) { const f32x4 v0 = acc[ai][bj][m][0] * sc, v1 = acc[ai][bj][m][1] * sc;
                    if (dov) ss += ((v0[0] * v0[0] + v0[1] * v0[1]) + (v0[2] * v0[2] + v0[3] * v0[3])) + ((v1[0] * v1[0] + v1[1] * v1[1]) + (v1[2] * v1[2] + v1[3] * v1[3]));
                    u32x4 w; w.x = cvt_pk_bf16(v0[0], v0[1]); w.y = cvt_pk_bf16(v0[2], v0[3]); w.z = cvt_pk_bf16(v1[0], v1[1]); w.w = cvt_pk_bf16(v1[2], v1[3]);
                    *(u32x4*)(rowp + bj * HALF) = w; }
                if (dov) { ss += __shfl_xor(ss, 16); ss += __shfl_xor(ss, 32); if (fq == 0) vss[(size_t)row * 32 + (u.pn - v_lo) * 4 + wc] = ss; }
            }
    }
};
struct EpiVT {
    static constexpr bool PERM = true, AFTER_DRAIN = false;
    bf16_t* O; int ldc; const float* rowss;
    __device__ __forceinline__ void operator()(const f32x4 (&acc)[2][2][4][2], const Unit& u, int wr, int wc, int fr, int fq) const {
        const int row0 = u.pm * BM + wr * 64 + fr; const int col0 = u.pn * BM + wc * 32 + 8 * fq;
        f32x4 cs[2][2];
#pragma unroll
        for (int bj = 0; bj < 2; ++bj)
#pragma unroll
            for (int n = 0; n < 2; ++n)
                cs[bj][n] = *(const f32x4*)(rowss + col0 + bj * HALF + 4 * n);
#pragma unroll
        for (int ai = 0; ai < 2; ++ai)
#pragma unroll
            for (int m = 0; m < 4; ++m) { bf16_t* rowp = O + (size_t)(row0 + ai * HALF + m * 16) * ldc + col0;
#pragma unroll
                for (int bj = 0; bj < 2; ++bj) { const f32x4 v0 = acc[ai][bj][m][0] * cs[bj][0], v1 = acc[ai][bj][m][1] * cs[bj][1];
                    u32x4 w; w.x = cvt_pk_bf16(v0[0], v0[1]); w.y = cvt_pk_bf16(v0[2], v0[3]); w.z = cvt_pk_bf16(v1[0], v1[1]); w.w = cvt_pk_bf16(v1[2], v1[3]);
                    *(u32x4*)(rowp + bj * HALF) = w; } }
    }
};
struct EpiOut {
    static constexpr bool PERM = true, AFTER_DRAIN = false;
    const float* base32; bf16_t* xb; float* rowss; int row_off;
    __device__ __forceinline__ void operator()(const f32x4 (&acc)[2][2][4][2], const Unit& u, int wr, int wc, int fr, int fq) const {
        const int row0 = row_off + u.pm * BM + wr * 64 + fr; const int col0 = u.pn * BM + wc * 32 + 8 * fq;
#pragma unroll
        for (int ai = 0; ai < 2; ++ai)
#pragma unroll
            for (int m = 0; m < 4; ++m) { const int row = row0 + ai * HALF + m * 16; const size_t off = (size_t)row * 1024 + col0; float ss = 0.f;
#pragma unroll
                for (int bj = 0; bj < 2; ++bj) { const size_t o = off + bj * HALF; f32x4 b0, b1;
                    if (base32) { b0 = *(const f32x4*)(base32 + o); b1 = *(const f32x4*)(base32 + o + 4); }
                    else { const u32x4 w = *(const u32x4*)(xb + o);
                        b0[0] = __uint_as_float(w.x << 16); b0[1] = __uint_as_float(w.x & 0xffff0000u); b0[2] = __uint_as_float(w.y << 16); b0[3] = __uint_as_float(w.y & 0xffff0000u);
                        b1[0] = __uint_as_float(w.z << 16); b1[1] = __uint_as_float(w.z & 0xffff0000u); b1[2] = __uint_as_float(w.w << 16); b1[3] = __uint_as_float(w.w & 0xffff0000u); }
                    const f32x4 x0 = b0 + acc[ai][bj][m][0], x1 = b1 + acc[ai][bj][m][1];
                    ss += ((x0[0] * x0[0] + x0[1] * x0[1]) + (x0[2] * x0[2] + x0[3] * x0[3])) + ((x1[0] * x1[0] + x1[1] * x1[1]) + (x1[2] * x1[2] + x1[3] * x1[3]));
                    u32x4 w2; w2.x = cvt_pk_bf16(x0[0], x0[1]); w2.y = cvt_pk_bf16(x0[2], x0[3]); w2.z = cvt_pk_bf16(x1[0], x1[1]); w2.w = cvt_pk_bf16(x1[2], x1[3]);
                    *(u32x4*)(xb + o) = w2; }
                ss += __shfl_xor(ss, 16); ss += __shfl_xor(ss, 32); if (fq == 0) rowss[(size_t)row * 16 + u.pn * 4 + wc] = ss; }
    }
};
template <class Epi, class Sched, bool ALIGN_EPI = false, bool SP2 = false>
__device__ __forceinline__ void gemm_phase(PG8_LAS unsigned char* lds, const Gemm g, const Sched& S, const Epi& E, int wave_s) {
    int tid_l = my_tid(wave_s); const int tid = tid_l, wid = __builtin_amdgcn_readfirstlane(tid >> 6), lane = tid & 63, wr = wid >> 2, wc = wid & 3, fr = lane & 15, fq = lane >> 4;
    const int K = g.K, nt = K / BK;
    unsigned voffA[2], voffB[2];
#pragma unroll
    for (int i = 0; i < 2; ++i) { int R, C; stage_rc(tid * 16 + i * 8192, R, C); const int Rb = Epi::PERM ? ((R & ~31) + perm32(R & 31)) : R;
        voffA[i] = (unsigned)(R * K + C) * 2u; voffB[i] = (unsigned)(Rb * K + C) * 2u; }
    const size_t kstep = (size_t)(BK * 2);
    const size_t hstep = (size_t)HALF * K * 2;
    const size_t tstep = 2 * hstep;
    const unsigned ldsw = (unsigned)wid * 1024u;
    const int aoff = lds_byte(wr * 64 + fr, fq * 8), boff = lds_byte(wc * 32 + fr, fq * 8);
#define PG8_SA(b, h) (((b) * 2 + (h)) * HTB)
#define PG8_SB(b, h) ((4 + (b) * 2 + (h)) * HTB)
#define PG8_STAGE(bufoff, gbase, voff) do { _Pragma("unroll") for (int _i = 0; _i < 2; ++_i) \
        __builtin_amdgcn_global_load_lds((const unsigned*)((const char*)(gbase) + (voff)[_i]), (PG8_LAS unsigned*)(lds + (bufoff) + ldsw + _i * 8192), 16, 0, 0); } while (0)
#define PG8_LDA(dst, b, h) do { _Pragma("unroll") for (int m = 0; m < 4; ++m) _Pragma("unroll") for (int k = 0; k < 2; ++k) dst[m][k] = *(const PG8_LAS bf16x8*)(lds + PG8_SA(b, h) + aoff + m * 2048 + k * 1024); } while (0)
#define PG8_LDB(dst, b, h) do { _Pragma("unroll") for (int n = 0; n < 2; ++n) _Pragma("unroll") for (int k = 0; k < 2; ++k) dst[n][k] = *(const PG8_LAS bf16x8*)(lds + PG8_SB(b, h) + boff + n * 2048 + k * 1024); } while (0)
#define PG8_MMA(ai, bj, At, Bt) do { __builtin_amdgcn_s_setprio(1); _Pragma("unroll") for (int m = 0; m < 4; ++m) _Pragma("unroll") for (int n = 0; n < 2; ++n) _Pragma("unroll") for (int k = 0; k < 2; ++k) \
        acc[ai][bj][m][n] = __builtin_amdgcn_mfma_f32_16x16x32_bf16(Bt[n][k], At[m][k], acc[ai][bj][m][n], 0, 0, 0); __builtin_amdgcn_s_setprio(0); } while (0)
#define PG8_WAIT_V(n) asm volatile("s_waitcnt vmcnt(" #n ")" ::: "memory")
#define PG8_WAIT_L(n) asm volatile("s_waitcnt lgkmcnt(" #n ")" ::: "memory")
#define PG8_BAR __builtin_amdgcn_s_barrier()
#define PG8_SCHED __builtin_amdgcn_sched_barrier(0)
    Unit cur, nxt; int ui = 0;
    if (!S.next(0, cur)) return;
    f32x4 acc[2][2][4][2];
#pragma unroll
    for (int a = 0; a < 2; ++a)
#pragma unroll
        for (int b = 0; b < 2; ++b)
#pragma unroll
            for (int m = 0; m < 4; ++m)
#pragma unroll
                for (int n = 0; n < 2; ++n) acc[a][b][m][n] = (f32x4){0.f, 0.f, 0.f, 0.f};
    bf16x8 At[4][2], B0[2][2], B1[2][2];
    const char* cA = (const char*)g.A + (size_t)cur.pm * tstep; const char* cB = (const char*)g.Bt + (size_t)cur.pn * tstep;
    S.a_ready(cur);
    if constexpr (SP2) {
        PG8_STAGE(PG8_SB(0, 0), cB, voffB); PG8_STAGE(PG8_SB(0, 1), cB + hstep, voffB); PG8_STAGE(PG8_SA(0, 0), cA, voffA); PG8_STAGE(PG8_SA(0, 1), cA + hstep, voffA);
        if (wr == 1) PG8_BAR;
        PG8_WAIT_V(2); PG8_BAR;
        PG8_STAGE(PG8_SB(1, 0), cB + kstep, voffB); PG8_STAGE(PG8_SA(1, 0), cA + kstep, voffA); PG8_STAGE(PG8_SB(1, 1), cB + hstep + kstep, voffB);
        PG8_WAIT_V(6); PG8_BAR;
    } else {
        PG8_STAGE(PG8_SB(0, 0), cB, voffB); PG8_STAGE(PG8_SA(0, 0), cA, voffA); PG8_STAGE(PG8_SB(0, 1), cB + hstep, voffB); PG8_STAGE(PG8_SA(0, 1), cA + hstep, voffA);
        if (wr == 1) PG8_BAR;
        PG8_WAIT_V(4); PG8_BAR;
        PG8_STAGE(PG8_SB(1, 0), cB + kstep, voffB); PG8_STAGE(PG8_SA(1, 0), cA + kstep, voffA); PG8_STAGE(PG8_SB(1, 1), cB + hstep + kstep, voffB);
        PG8_WAIT_V(6); PG8_BAR;
    }
    for (;;) {
        const bool has_next = S.next(ui + 1, nxt);
        const char* nA = has_next ? (const char*)g.A + (size_t)nxt.pm * tstep : cA; const char* nB = has_next ? (const char*)g.Bt + (size_t)nxt.pn * tstep : cB;
        for (int t = 0; t < nt; t += 2) {
            const bool last = (t == nt - 2);
            const char* a1 = cA + (size_t)(t + 1) * kstep;
            const char* a2 = last ? nA : cA + (size_t)(t + 2) * kstep; const char* b2 = last ? nB : cB + (size_t)(t + 2) * kstep;
            const char* a3 = a2 + kstep; const char* b3 = b2 + kstep;
            if (last && has_next) S.a_ready(nxt);
            if constexpr (SP2) {
            PG8_LDB(B0, 0, 0); PG8_LDB(B1, 0, 1); PG8_SCHED; PG8_LDA(At, 0, 0); PG8_STAGE(PG8_SA(1, 1), a1 + hstep, voffA);
            PG8_WAIT_V(8); PG8_WAIT_L(0); PG8_BAR; PG8_MMA(0, 0, At, B0); PG8_MMA(0, 1, At, B1); PG8_BAR; PG8_SCHED;
            PG8_LDA(At, 0, 1); PG8_STAGE(PG8_SB(0, 0), b2, voffB); PG8_STAGE(PG8_SB(0, 1), b2 + hstep, voffB); PG8_STAGE(PG8_SA(0, 0), a2, voffA);
            PG8_WAIT_V(8); PG8_WAIT_L(0); PG8_BAR; PG8_MMA(1, 0, At, B0); PG8_MMA(1, 1, At, B1); PG8_BAR; PG8_SCHED;
            PG8_LDB(B0, 1, 0); PG8_LDB(B1, 1, 1); PG8_SCHED; PG8_LDA(At, 1, 0); PG8_STAGE(PG8_SA(0, 1), a2 + hstep, voffA);
            PG8_WAIT_V(8); PG8_WAIT_L(0); PG8_BAR; PG8_MMA(0, 0, At, B0); PG8_MMA(0, 1, At, B1); PG8_BAR; PG8_SCHED;
            PG8_LDA(At, 1, 1); PG8_STAGE(PG8_SB(1, 0), b3, voffB); PG8_STAGE(PG8_SB(1, 1), b3 + hstep, voffB); PG8_STAGE(PG8_SA(1, 0), a3, voffA);
            PG8_WAIT_V(8); PG8_WAIT_L(0); PG8_BAR; PG8_MMA(1, 0, At, B0); PG8_MMA(1, 1, At, B1); PG8_BAR; PG8_SCHED;
            } else {
            PG8_LDB(B0, 0, 0); PG8_SCHED; PG8_LDA(At, 0, 0); PG8_STAGE(PG8_SA(1, 1), a1 + hstep, voffA);
            PG8_WAIT_L(8); PG8_BAR; PG8_WAIT_L(0); PG8_MMA(0, 0, At, B0); PG8_BAR; PG8_SCHED;
            PG8_LDB(B1, 0, 1); PG8_STAGE(PG8_SB(0, 0), b2, voffB);
            PG8_BAR; PG8_WAIT_L(0); PG8_MMA(0, 1, At, B1); PG8_BAR;
            PG8_LDA(At, 0, 1); PG8_STAGE(PG8_SA(0, 0), a2, voffA);
            PG8_BAR; PG8_WAIT_L(0); PG8_MMA(1, 0, At, B0); PG8_BAR; PG8_SCHED;
            PG8_STAGE(PG8_SB(0, 1), b2 + hstep, voffB);
            PG8_WAIT_V(6); PG8_BAR; PG8_MMA(1, 1, At, B1); PG8_BAR;
            PG8_LDB(B0, 1, 0); PG8_SCHED; PG8_LDA(At, 1, 0); PG8_STAGE(PG8_SA(0, 1), a2 + hstep, voffA);
            PG8_WAIT_L(8); PG8_BAR; PG8_WAIT_L(0); PG8_MMA(0, 0, At, B0); PG8_BAR; PG8_SCHED;
            PG8_LDB(B1, 1, 1); PG8_STAGE(PG8_SB(1, 0), b3, voffB);
            PG8_BAR; PG8_WAIT_L(0); PG8_MMA(0, 1, At, B1); PG8_BAR;
            PG8_LDA(At, 1, 1); PG8_STAGE(PG8_SA(1, 0), a3, voffA);
            PG8_BAR; PG8_WAIT_L(0); PG8_MMA(1, 0, At, B0); PG8_BAR; PG8_SCHED;
            PG8_STAGE(PG8_SB(1, 1), b3 + hstep, voffB);
            PG8_WAIT_V(6); PG8_BAR; PG8_MMA(1, 1, At, B1); PG8_BAR;
            }
        }
        if constexpr (ALIGN_EPI) { if (wr == 0) PG8_BAR; }
        if constexpr (!Epi::AFTER_DRAIN) { E(acc, cur, wr, wc, fr, fq); S.done(cur); }
        if (!has_next) break;
#pragma unroll
        for (int a = 0; a < 2; ++a)
#pragma unroll
            for (int b = 0; b < 2; ++b)
#pragma unroll
                for (int m = 0; m < 4; ++m)
#pragma unroll
                    for (int n = 0; n < 2; ++n) acc[a][b][m][n] = (f32x4){0.f, 0.f, 0.f, 0.f};
        cur = nxt; cA = nA; cB = nB; ++ui;
        if constexpr (ALIGN_EPI) { if (wr == 1) PG8_BAR; }
    }
    PG8_WAIT_V(0);
    if constexpr (!ALIGN_EPI) { if (wr == 0) PG8_BAR; }
    PG8_BAR;
    if constexpr (Epi::AFTER_DRAIN) { E.fused(acc, cur, wr, wc, fr, fq, lds, wid, lane); S.done(cur); }
#undef PG8_SA
#undef PG8_SB
#undef PG8_STAGE
#undef PG8_LDA
#undef PG8_LDB
#undef PG8_MMA
#undef PG8_WAIT_V
#undef PG8_WAIT_L
#undef PG8_BAR
#undef PG8_SCHED
}
}
#define LAS __attribute__((address_space(3)))
typedef unsigned short bf16;
typedef short bf16x8 __attribute__((ext_vector_type(8)));
typedef float f32x16 __attribute__((ext_vector_type(16)));
typedef float f32x4 __attribute__((ext_vector_type(4)));
typedef unsigned u32x4 __attribute__((ext_vector_type(4)));
typedef unsigned u32x2 __attribute__((ext_vector_type(2)));
typedef float f32x2_t __attribute__((ext_vector_type(2))); typedef __bf16 bf16x2_t __attribute__((ext_vector_type(2)));
constexpr int DM = 1024, SEQ = 4096, MTOK = 32768, HTOK = 16384, BR = 2048, NHEAD = 16;
constexpr size_t MiB = 1u << 20;
constexpr size_t WS_ROWSS = 1 * MiB;
constexpr size_t WS_VSS = 3 * MiB;
constexpr size_t WS_RSTD = 6 * MiB;
constexpr size_t WS_WM = 5 * MiB;
constexpr size_t WS_W = 8 * MiB;
constexpr size_t W_ATT_IN = 0, W_ATT_OUT = 32 * MiB, W_SGU_IN = 40 * MiB, W_SGU_OUT = 64 * MiB;
constexpr size_t WS_XB = 80 * MiB;
constexpr size_t WS_ACT = 144 * MiB;
constexpr size_t ACT_STRIDE = (size_t)HTOK * BR;
constexpr size_t WS_END = 400 * MiB;
constexpr int RING_BYTES = 131072, LDS_BYTES = 147456;
constexpr float LOG2E = 1.4426950408889634f;
constexpr float QSCALE = 0.125f * LOG2E;
constexpr int NPHASE = 19;

__device__ __forceinline__ float bf2f(unsigned short b) { return __uint_as_float((unsigned)b << 16); }
__device__ __forceinline__ unsigned pk2(float lo, float hi) { f32x2_t v = {lo, hi}; bf16x2_t b = __builtin_convertvector(v, bf16x2_t); return __builtin_bit_cast(unsigned, b); }
__device__ __forceinline__ float wave_sum(float v) {
#pragma unroll
    for (int o = 1; o < 64; o <<= 1) v += __shfl_xor(v, o);
    return v;
}
__device__ __forceinline__ float swap_max(float m) { auto rr = __builtin_amdgcn_permlane32_swap(__float_as_uint(m), __float_as_uint(m), false, false); return fmaxf(__uint_as_float(rr[0]), __uint_as_float(rr[1])); }
__device__ __forceinline__ float swap_sum(float m) { auto rr = __builtin_amdgcn_permlane32_swap(__float_as_uint(m), __float_as_uint(m), false, false); return __uint_as_float(rr[0]) + __uint_as_float(rr[1]); }
__device__ __forceinline__ float silu_f(float x) { return x * __builtin_amdgcn_rcpf(1.0f + __builtin_amdgcn_exp2f(-LOG2E * x)); }
__device__ __forceinline__ int crow(int r, int hi) { return (r & 3) + 8 * (r >> 2) + 4 * hi; }
__device__ __forceinline__ float fadd_s(float a, float b) { float r; asm("v_add_f32_e32 %0, %1, %2" : "=v"(r) : "v"(a), "v"(b)); return r; }
__device__ __forceinline__ float max3f_s(float a, float b, float c) { float r; asm("v_max3_f32 %0, %1, %2, %3" : "=v"(r) : "v"(a), "v"(b), "v"(c)); return r; }
__device__ __forceinline__ float max2f_s(float a, float b) { float r; asm("v_max_f32_e32 %0, %1, %2" : "=v"(r) : "v"(a), "v"(b)); return r; }
#define MFMA32(a, b, c) __builtin_amdgcn_mfma_f32_32x32x16_bf16((a), (b), (c), 0, 0, 0)

struct Args { const float* in[17]; float* out; unsigned char* ws; int ph_lo, ph_hi, pad0, pad1; };

__device__ __forceinline__ void transpose_item(const float* W, const float* gain, int K, int N, bf16* WT, int n0, int dst_row0, int k0, LAS float* scr, int lane) {
#pragma unroll
    for (int i = 0; i < 32; ++i) { const int kk = 2 * i + (lane >> 5); const float gv = gain ? gain[k0 + kk] : 1.f; scr[kk * 33 + (lane & 31)] = W[(size_t)(k0 + kk) * N + n0 + (lane & 31)] * gv; }
    asm volatile("s_waitcnt lgkmcnt(0)" ::: "memory");
    const int c = lane & 7;
#pragma unroll
    for (int j = 0; j < 4; ++j) { const int n = (lane >> 3) + 8 * j; const LAS float* s = scr + (8 * c) * 33 + n;
        u32x4 o; o.x = pk2(s[0 * 33], s[1 * 33]); o.y = pk2(s[2 * 33], s[3 * 33]); o.z = pk2(s[4 * 33], s[5 * 33]); o.w = pk2(s[6 * 33], s[7 * 33]);
        *(u32x4*)(WT + (size_t)(dst_row0 + n) * K + k0 + 8 * c) = o; }
    asm volatile("s_waitcnt lgkmcnt(0)" ::: "memory");
}
__device__ __forceinline__ void prologue(const Args& a, LAS unsigned char* lds, int vcu, int G, int wave_s) {
    int tid_l = my_tid(wave_s); const int tid = tid_l, lane = tid & 63, wave = __builtin_amdgcn_readfirstlane(tid >> 6);
    LAS float* scr = (LAS float*)(lds + wave * 16384);
    const int gw = vcu * 8 + wave, NGW = G * 8;
    bf16* wbase = (bf16*)(a.ws + WS_W);
    constexpr int I_AI = 16 * 256, I_AO = 32 * 32, I_SI = 16 * 192, I_SO = 32 * 32, I_J = I_AI + I_AO + I_SI + I_SO;
    for (int it = gw; it < 2 * I_J; it += NGW) {
        const int j = it / I_J; int r = it % I_J;
        if (r < I_AI) { const int kb = r / 256, nb = r % 256, n0 = nb * 32; const int dr = n0 < 4096 ? n0 : (n0 < 6144 ? n0 + 2048 : n0 - 2048);
            transpose_item(a.in[3] + (size_t)j * 1024 * 8192, a.in[2] + j * 1024, 1024, 8192, wbase + (W_ATT_IN + (size_t)j * 16 * MiB) / 2, n0, dr, kb * 64, scr, lane); continue; } r -= I_AI;
        if (r < I_AO) { const int kb = r / 32, nb = r % 32;
            transpose_item(a.in[9] + (size_t)j * 2048 * 1024, nullptr, 2048, 1024, wbase + (W_ATT_OUT + (size_t)j * 4 * MiB) / 2, nb * 32, nb * 32, kb * 64, scr, lane); continue; } r -= I_AO;
        if (r < I_SI) { const int kb = r / 192, nb = r % 192, n0 = nb * 32;
            const int dr = n0 < 2048 ? (n0 >> 7) * 256 + (n0 & 127) : (n0 < 4096 ? n0 + 2048 : ((n0 - 4096) >> 7) * 256 + 128 + (n0 & 127));
            transpose_item(a.in[11] + (size_t)j * 1024 * 6144, a.in[10] + j * 1024, 1024, 6144, wbase + (W_SGU_IN + (size_t)j * 12 * MiB) / 2, n0, dr, kb * 64, scr, lane); continue; } r -= I_SI;
        { const int kb = r / 32, nb = r % 32;
            transpose_item(a.in[15] + (size_t)j * 2048 * 1024, nullptr, 2048, 1024, wbase + (W_SGU_OUT + (size_t)j * 4 * MiB) / 2, nb * 32, nb * 32, kb * 64, scr, lane); }
    }
    const float* x = a.in[0]; bf16* xb = (bf16*)(a.ws + WS_XB); float* rstdc = (float*)(a.ws + WS_RSTD);
    for (int m0 = gw * 4; m0 < MTOK; m0 += NGW * 4) {
        f32x4 v[4][4];
#pragma unroll
        for (int q = 0; q < 4; ++q) { const f32x4* xr = (const f32x4*)(x + (size_t)(m0 + q) * DM) + lane;
#pragma unroll
            for (int j = 0; j < 4; ++j) v[q][j] = xr[64 * j]; }
#pragma unroll
        for (int q = 0; q < 4; ++q) { const int m = m0 + q; float s = 0.f;
#pragma unroll
            for (int j = 0; j < 4; ++j) s += (v[q][j][0] * v[q][j][0] + v[q][j][1] * v[q][j][1]) + (v[q][j][2] * v[q][j][2] + v[q][j][3] * v[q][j][3]);
            s = wave_sum(s);
            u32x2* o8 = (u32x2*)(xb + (size_t)m * DM) + lane;
#pragma unroll
            for (int j = 0; j < 4; ++j) { u32x2 w; w.x = pk2(v[q][j][0], v[q][j][1]); w.y = pk2(v[q][j][2], v[q][j][3]); o8[64 * j] = w; }
            if (lane == 0) rstdc[m] = 1.0f / sqrtf(s * (1.0f / 1024.0f) + 1e-6f); }
    }
    const float* wsrc = a.in[13]; bf16* wm = (bf16*)(a.ws + WS_WM);
    for (int i = vcu * 512 + tid; i < 2 * 16 * 128 * 128 / 4; i += G * 512) {
        const f32x4 w = *((const f32x4*)wsrc + i); const int e = i * 4, s = e & 127, t = (e >> 7) & 127;
        u32x2 o; o.x = pk2(s <= t ? w[0] : 0.f, s + 1 <= t ? w[1] : 0.f); o.y = pk2(s + 2 <= t ? w[2] : 0.f, s + 3 <= t ? w[3] : 0.f);
        *((u32x2*)wm + i) = o;
    }
}

namespace att {
constexpr int KST = 16384, VST = 16384, NSK = 3, NSV = 3;
constexpr int OFF_K = 0, OFF_V = NSK * KST, OFF_OSTG = 65536, OSTG_W = 32 * 272, OFF_TB = 102400, TBC = 324, OFF_END = OFF_TB + 512 + 4 * TBC * 4;
static_assert(OFF_END <= RING_BYTES && OFF_OSTG + 4 * OSTG_W <= OFF_TB && OFF_V + NSV * VST <= OFF_TB, "attention LDS map");
}
#define SGB(mask, n) __builtin_amdgcn_sched_group_barrier((mask), (n), 0)
template <int ABL> __device__ __forceinline__ void attn_unit(LAS unsigned char* lds, const bf16* Qb, bf16* Yb, const bf16* Kb, const bf16* Gb, const bf16* VTb, const float* rel_bias, const float* subln, float lam, float c1, int bl, int h, int qb, int wave_s) {
    using namespace att;
    int tid_l = my_tid(wave_s); const int tid = tid_l, lane = tid & 63, r32 = lane & 31, hi = lane >> 5;
    const int wid = __builtin_amdgcn_readfirstlane(tid >> 6), mp = wid >> 2, wq = wid & 3;
    const int rowbase = bl * SEQ, q0 = qb * 128, wfirst = q0 + 32 * wq;
    LAS float* sg = (LAS float*)(lds + OFF_TB); LAS float* tbl = sg + 128;
    if (tid < 128) sg[tid] = subln[tid];
    { const float b31 = rel_bias[31 * 16 + h];
      for (int idx = tid; idx < 4 * TBC; idx += 512) { const int c_ = idx / TBC, i_ = idx % TBC + c_, n = 223 - i_; float v = 0.f;
        if (n < 0) v = -INFINITY;
        else if (n < 113) { int bk = n; if (n >= 16) bk = 16 + (n >= 19) + (n >= 21) + (n >= 24) + (n >= 27) + (n >= 31) + (n >= 35) + (n >= 40) + (n >= 46) + (n >= 52) + (n >= 59) + (n >= 67) + (n >= 77) + (n >= 87) + (n >= 99);
            v = (rel_bias[bk * 16 + h] - b31) * LOG2E; }
        tbl[idx] = v; } }
    const int nt = 2 * (qb + 1);
    const int krow_l = 4 * wid + (lane >> 4), kchunk = (lane & 15) ^ (krow_l & 15);
    const bf16* ksrc = Kb + (size_t)(rowbase + krow_l) * BR + h * 128 + kchunk * 8;
    const int vdv_l = 8 * wid + (lane >> 3), vchunk = (lane & 7) ^ ((vdv_l >> 1) & 7);
    const bf16* vsrc = VTb + (size_t)(h * 128 + vdv_l) * HTOK + rowbase + vchunk * 8;
#define ATT_DMAK(t, sk) do { _Pragma("unroll") for (int i_ = 0; i_ < 2; ++i_) \
        __builtin_amdgcn_global_load_lds((const unsigned*)(ksrc + (size_t)(64 * (t) + 32 * i_) * BR), (LAS unsigned*)(lds + OFF_K + (sk) * KST + (wid + 8 * i_) * 1024), 16, 0, 0); } while (0)
#define ATT_DMAV(t, sv) do { _Pragma("unroll") for (int i_ = 0; i_ < 2; ++i_) \
        __builtin_amdgcn_global_load_lds((const unsigned*)(vsrc + (size_t)(64 * i_) * HTOK + 64 * (t)), (LAS unsigned*)(lds + OFF_V + (sv) * VST + (wid + 8 * i_) * 1024), 16, 0, 0); } while (0)
#define DMAK1(t, sk, i_) do { if ((t) < nt) __builtin_amdgcn_global_load_lds((const unsigned*)(ksrc + (size_t)(64 * (t) + 32 * (i_)) * BR), (LAS unsigned*)(lds + OFF_K + (sk) * KST + (wid + 8 * (i_)) * 1024), 16, 0, 0); } while (0)
#define DMAV1(t, sv, i_) do { if ((t) < nt) __builtin_amdgcn_global_load_lds((const unsigned*)(vsrc + (size_t)(64 * (i_)) * HTOK + 64 * (t)), (LAS unsigned*)(lds + OFF_V + (sv) * VST + (wid + 8 * (i_)) * 1024), 16, 0, 0); } while (0)
    ATT_DMAK(0, 0); ATT_DMAK(1, 1); ATT_DMAV(0, 0); if (nt > 2) ATT_DMAK(2, 2); ATT_DMAV(1, 1);
    bf16x8 qf[4];
    { const bf16* qp = Qb + (size_t)(rowbase + wfirst + r32) * BR + h * 128 + mp * 64 + hi * 8;
#pragma unroll
      for (int c = 0; c < 4; ++c) qf[c] = *(const bf16x8*)(qp + 16 * c); }
    const int pirow = (r32 & ~12) | ((r32 & 4) << 1) | ((r32 & 8) >> 1);
    int kaddr[4], vaddr[4];
#pragma unroll
    for (int c = 0; c < 4; ++c) { kaddr[c] = OFF_K + pirow * 256 + (((mp * 8 + 2 * c + hi) ^ (pirow & 15)) << 4); vaddr[c] = OFF_V + r32 * 128 + (((2 * c + hi) ^ ((r32 >> 1) & 7)) << 4); }
    float mu = 0.f, l = 0.f; f32x16 o[4], negm;
#pragma unroll
    for (int r = 0; r < 16; ++r) { o[0][r] = 0.f; o[1][r] = 0.f; o[2][r] = 0.f; o[3][r] = 0.f; }
    const int nact = min(nt, (wfirst + 31) / 64 + 1);
#define ATT_NEAR(x0, x1, tt) do { if (64 * (tt) + 63 + 113 > wfirst) { const int i0_ = 223 - (wfirst + r32 - 64 * (tt) - 8 * hi), c_ = i0_ & 3; const LAS float* tp_ = tbl + c_ * TBC + (i0_ - c_); f32x4 b_; \
        b_ = *(const LAS f32x4*)(tp_);      x0[0] += b_[0]; x0[1] += b_[1]; x0[2] += b_[2]; x0[3] += b_[3];     b_ = *(const LAS f32x4*)(tp_ + 4);  x0[4] += b_[0]; x0[5] += b_[1]; x0[6] += b_[2]; x0[7] += b_[3]; \
        b_ = *(const LAS f32x4*)(tp_ + 16); x0[8] += b_[0]; x0[9] += b_[1]; x0[10] += b_[2]; x0[11] += b_[3];  b_ = *(const LAS f32x4*)(tp_ + 20); x0[12] += b_[0]; x0[13] += b_[1]; x0[14] += b_[2]; x0[15] += b_[3]; \
        b_ = *(const LAS f32x4*)(tp_ + 32); x1[0] += b_[0]; x1[1] += b_[1]; x1[2] += b_[2]; x1[3] += b_[3];     b_ = *(const LAS f32x4*)(tp_ + 36); x1[4] += b_[0]; x1[5] += b_[1]; x1[6] += b_[2]; x1[7] += b_[3]; \
        b_ = *(const LAS f32x4*)(tp_ + 48); x1[8] += b_[0]; x1[9] += b_[1]; x1[10] += b_[2]; x1[11] += b_[3];  b_ = *(const LAS f32x4*)(tp_ + 52); x1[12] += b_[0]; x1[13] += b_[1]; x1[14] += b_[2]; x1[15] += b_[3]; } } while (0)
#define ATT_ROWMAX(x0, x1, mx) do { mx = fmaxf(fmaxf(x0[0], x1[0]), fmaxf(x0[1], x1[1])); \
        _Pragma("unroll") for (int r = 2; r < 16; r += 2) mx = fmaxf(fmaxf(mx, x0[r]), fmaxf(x1[r], fmaxf(x0[r + 1], x1[r + 1]))); mx = swap_max(mx); } while (0)
    bf16x8 pb[4], pc[4];
#pragma unroll
    for (int c = 0; c < 4; ++c) pc[c] = (bf16x8){0, 0, 0, 0, 0, 0, 0, 0};
    asm volatile("s_waitcnt vmcnt(6)" ::: "memory"); __builtin_amdgcn_s_barrier(); asm volatile("" ::: "memory");
    {
        f32x16 s0, s1;
#pragma unroll
        for (int r = 0; r < 16; ++r) { s0[r] = 0.f; s1[r] = 0.f; }
        bf16x8 kf[8];
#pragma unroll
        for (int c = 0; c < 4; ++c) { kf[2 * c] = *(const LAS bf16x8*)(lds + kaddr[c]); kf[2 * c + 1] = *(const LAS bf16x8*)(lds + kaddr[c] + 8192); }
#pragma unroll
        for (int c = 0; c < 4; ++c) { s0 = MFMA32(kf[2 * c], qf[c], s0); s1 = MFMA32(kf[2 * c + 1], qf[c], s1); }
        ATT_NEAR(s0, s1, 0);
        float mx; ATT_ROWMAX(s0, s1, mx);
        mu = mx; float sum = 0.f;
#pragma unroll
        for (int r = 0; r < 16; ++r) { negm[r] = -mx; s0[r] = __builtin_amdgcn_exp2f(s0[r] - mx); s1[r] = __builtin_amdgcn_exp2f(s1[r] - mx); sum += s0[r] + s1[r]; }
        l = sum;
        u32x4 w;
        w.x = pk2(s0[0], s0[1]); w.y = pk2(s0[2], s0[3]); w.z = pk2(s0[4], s0[5]); w.w = pk2(s0[6], s0[7]); pb[0] = __builtin_bit_cast(bf16x8, w);
        w.x = pk2(s0[8], s0[9]); w.y = pk2(s0[10], s0[11]); w.z = pk2(s0[12], s0[13]); w.w = pk2(s0[14], s0[15]); pb[1] = __builtin_bit_cast(bf16x8, w);
        w.x = pk2(s1[0], s1[1]); w.y = pk2(s1[2], s1[3]); w.z = pk2(s1[4], s1[5]); w.w = pk2(s1[6], s1[7]); pb[2] = __builtin_bit_cast(bf16x8, w);
        w.x = pk2(s1[8], s1[9]); w.y = pk2(s1[10], s1[11]); w.z = pk2(s1[12], s1[13]); w.w = pk2(s1[14], s1[15]); pb[3] = __builtin_bit_cast(bf16x8, w);
    }
    int sk1 = 1, sk3 = 0, sv0 = 0, sv2 = 2;
#define SBAR() __builtin_amdgcn_sched_barrier(0)
#define VLD(i) (*(const LAS bf16x8*)(vs_ + vaddr[(i) >> 2] + ((i) & 3) * 4096))
#define PVG(i, EXPS) do { o[(i) & 3] = MFMA32(vf[(i) % 4], PBI_[(i) >> 2], o[(i) & 3]); if ((i) + 4 < 16) vf[(i) % 4] = VLD((i) + 4); EXPS; SBAR(); } while (0)
#define EXG(nn, r, W, C) do { const float a_ = __builtin_amdgcn_exp2f(nn[r]), b_ = __builtin_amdgcn_exp2f(nn[r + 1]); sum = fadd_s(sum, a_); sumb = fadd_s(sumb, b_); W.C = pk2(a_, b_); asm volatile("" : "+v"(sum), "+v"(sumb), "+v"(W.C)); } while (0)
#define KLD(i) (*(const LAS bf16x8*)(ks + kaddr[(i) >> 1] + ((i) & 1) * 8192))
#define ATT_ITER(T_, PBIN, PBO_) do { bf16x8 (&PBI_)[4] = PBIN; \
        if (T_ + 2 < nt) asm volatile("s_waitcnt vmcnt(4)" ::: "memory"); else if (T_ + 1 < nt) asm volatile("s_waitcnt vmcnt(2)" ::: "memory"); else asm volatile("s_waitcnt vmcnt(0)" ::: "memory"); \
        __builtin_amdgcn_s_barrier(); asm volatile("" ::: "memory"); \
        if (T_ >= nact) { if (T_ + 3 < nt) ATT_DMAK(T_ + 3, sk3); if (T_ + 2 < nt) ATT_DMAV(T_ + 2, sv2); } \
        if (T_ < nact) { \
            const LAS unsigned char* vs_ = lds + sv0 * VST; \
            if (T_ + 1 < nact) { \
                const LAS unsigned char* ks = lds + sk1 * KST; \
                bf16x8 kf[4]; f32x16 n0, n1; float sum = 0.f, sumb = 0.f; u32x4 w0, w1, w2, w3; float alpha = 1.f; \
                kf[0] = KLD(0); kf[1] = KLD(1); kf[2] = KLD(2); SBAR(); \
                n0 = MFMA32(kf[0], qf[0], negm); kf[3] = KLD(3); SBAR(); \
                n1 = MFMA32(kf[1], qf[0], negm); kf[0] = KLD(4); SBAR(); \
                n0 = MFMA32(kf[2], qf[1], n0); kf[1] = KLD(5); SBAR(); \
                n1 = MFMA32(kf[3], qf[1], n1); kf[2] = KLD(6); SBAR(); \
                n0 = MFMA32(kf[0], qf[2], n0); kf[3] = KLD(7); SBAR(); \
                n1 = MFMA32(kf[1], qf[2], n1); SBAR(); \
                n0 = MFMA32(kf[2], qf[3], n0); SBAR(); \
                n1 = MFMA32(kf[3], qf[3], n1); \
                bf16x8 vf[4]; vf[0] = VLD(0); vf[1] = VLD(1); vf[2] = VLD(2); vf[3] = VLD(3); SBAR(); \
                ATT_NEAR(n0, n1, T_ + 1); \
                SBAR(); \
                PVG(0, EXG(n0, 0, w0, x)); PVG(1, EXG(n0, 2, w0, y); DMAK1(T_ + 3, sk3, 0)); PVG(2, EXG(n0, 4, w0, z)); PVG(3, EXG(n0, 6, w0, w)); \
                PVG(4, EXG(n0, 8, w1, x)); PVG(5, EXG(n0, 10, w1, y); DMAK1(T_ + 3, sk3, 1)); PVG(6, EXG(n0, 12, w1, z)); PVG(7, EXG(n0, 14, w1, w)); \
                PVG(8, EXG(n1, 0, w2, x)); PVG(9, EXG(n1, 2, w2, y); DMAV1(T_ + 2, sv2, 0)); PVG(10, EXG(n1, 4, w2, z)); PVG(11, EXG(n1, 6, w2, w)); \
                PVG(12, EXG(n1, 8, w3, x)); PVG(13, EXG(n1, 10, w3, y); DMAV1(T_ + 2, sv2, 1)); PVG(14, EXG(n1, 12, w3, z)); PVG(15, EXG(n1, 14, w3, w)); \
                float tot_ = sum + sumb; \
                if (__any(!(tot_ <= 4096.0f))) { \
                    float mx; ATT_ROWMAX(n0, n1, mx); \
                    const float dl = mx > 8.0f ? mx : 0.f; mu += dl; alpha = __builtin_amdgcn_exp2f(-dl); l *= alpha; \
                    float s2_ = 0.f; \
_Pragma("unroll") \
                    for (int r = 0; r < 16; ++r) { n0[r] = __builtin_amdgcn_exp2f(n0[r] - dl); n1[r] = __builtin_amdgcn_exp2f(n1[r] - dl); s2_ += n0[r] + n1[r]; negm[r] = -mu; \
                        o[0][r] *= alpha; o[1][r] *= alpha; o[2][r] *= alpha; o[3][r] *= alpha; } \
                    tot_ = s2_; \
                    w0.x = pk2(n0[0], n0[1]); w0.y = pk2(n0[2], n0[3]); w0.z = pk2(n0[4], n0[5]); w0.w = pk2(n0[6], n0[7]); \
                    w1.x = pk2(n0[8], n0[9]); w1.y = pk2(n0[10], n0[11]); w1.z = pk2(n0[12], n0[13]); w1.w = pk2(n0[14], n0[15]); \
                    w2.x = pk2(n1[0], n1[1]); w2.y = pk2(n1[2], n1[3]); w2.z = pk2(n1[4], n1[5]); w2.w = pk2(n1[6], n1[7]); \
                    w3.x = pk2(n1[8], n1[9]); w3.y = pk2(n1[10], n1[11]); w3.z = pk2(n1[12], n1[13]); w3.w = pk2(n1[14], n1[15]); \
                } \
                l += tot_; \
                PBO_[0] = __builtin_bit_cast(bf16x8, w0); PBO_[1] = __builtin_bit_cast(bf16x8, w1); PBO_[2] = __builtin_bit_cast(bf16x8, w2); PBO_[3] = __builtin_bit_cast(bf16x8, w3); \
            } else { \
                bf16x8 vf[4]; vf[0] = VLD(0); vf[1] = VLD(1); vf[2] = VLD(2); vf[3] = VLD(3); SBAR(); \
                PVG(0, (void)0); PVG(1, DMAK1(T_ + 3, sk3, 0)); PVG(2, (void)0); PVG(3, (void)0); PVG(4, (void)0); PVG(5, DMAK1(T_ + 3, sk3, 1)); PVG(6, (void)0); PVG(7, (void)0); \
                PVG(8, (void)0); PVG(9, DMAV1(T_ + 2, sv2, 0)); PVG(10, (void)0); PVG(11, (void)0); PVG(12, (void)0); PVG(13, DMAV1(T_ + 2, sv2, 1)); PVG(14, (void)0); PVG(15, (void)0); \
            } \
        } \
        sk1 = (sk1 == 2) ? 0 : sk1 + 1; sk3 = (sk3 == 2) ? 0 : sk3 + 1; sv0 = (sv0 == 2) ? 0 : sv0 + 1; sv2 = (sv2 == 2) ? 0 : sv2 + 1; \
    } while (0)
    if (mp == 1) __builtin_amdgcn_s_setprio(1);
#pragma unroll 1
    for (int t = 0; t < (ABL == 5 ? 0 : nt); t += 2) { ATT_ITER(t, pb, pc); ATT_ITER(t + 1, pc, pb); }
    if (mp == 1) __builtin_amdgcn_s_setprio(0);
#undef ATT_ITER
#undef KLD
#undef SBAR
#undef VLD
#undef PVG
#undef EXG
#undef ATT_DMAK
#undef DMAK1
#undef DMAV1
#undef ATT_DMAV
#undef ATT_NEAR
#undef ATT_ROWMAX
    asm volatile("s_waitcnt vmcnt(0) lgkmcnt(0)" ::: "memory"); __builtin_amdgcn_s_barrier(); asm volatile("" ::: "memory");
    const float inv = 1.0f / swap_sum(l);
    u32x4 gpre[8];
    if (mp == 0) {
#pragma unroll
        for (int i = 0; i < 8; ++i) { const int p = lane + 64 * i, row = p >> 4, ch = p & 15; gpre[i] = *(const u32x4*)(Gb + (size_t)(rowbase + wfirst + row) * BR + h * 128 + ch * 8); }
    }
    LAS float* oc = (LAS float*)lds + wq * 4096 + lane;
    if (mp == 1) {
#pragma unroll
        for (int b = 0; b < 4; ++b)
#pragma unroll
            for (int r = 0; r < 16; ++r) oc[(b * 16 + r) * 64] = o[b][r] * inv;
    }
    __syncthreads();
    if (mp == 0) {
        float ss = 0.f;
#pragma unroll
        for (int b = 0; b < 4; ++b)
#pragma unroll
            for (int r = 0; r < 16; ++r) { const float d = o[b][r] * inv - lam * oc[(b * 16 + r) * 64]; o[b][r] = d; ss += d * d; }
        ss = swap_sum(ss);
        const float rs = c1 / sqrtf(ss * (1.0f / 128.0f) + 1e-6f);
        LAS unsigned char* stg = lds + OFF_OSTG + wq * OSTG_W;
#pragma unroll
        for (int b = 0; b < 4; ++b)
#pragma unroll
            for (int g4 = 0; g4 < 4; ++g4) { const int dv0 = 32 * b + 8 * g4 + 4 * hi; const f32x4 gg = *(const LAS f32x4*)(sg + dv0);
                u32x2 w; w.x = pk2(o[b][4 * g4] * rs * gg[0], o[b][4 * g4 + 1] * rs * gg[1]); w.y = pk2(o[b][4 * g4 + 2] * rs * gg[2], o[b][4 * g4 + 3] * rs * gg[3]);
                *(LAS u32x2*)(stg + r32 * 272 + dv0 * 2) = w; }
        asm volatile("s_waitcnt lgkmcnt(0)" ::: "memory");
#pragma unroll
        for (int i = 0; i < 8; ++i) { const int p = lane + 64 * i, row = p >> 4, ch = p & 15;
            const u32x4 ov = *(const LAS u32x4*)(stg + row * 272 + ch * 16);
            const size_t goff = (size_t)(rowbase + wfirst + row) * BR + h * 128 + ch * 8;
            const u32x4 gv = gpre[i]; u32x4 y;
#pragma unroll
            for (int e = 0; e < 4; ++e) { const float o0 = __uint_as_float(ov[e] << 16), o1 = __uint_as_float(ov[e] & 0xffff0000u), g0 = __uint_as_float(gv[e] << 16), g1 = __uint_as_float(gv[e] & 0xffff0000u);
                y[e] = pk2(o0 * silu_f(g0), o1 * silu_f(g1)); }
            *(u32x4*)(Yb + goff) = y; }
    }
    __syncthreads();
}

struct SguV { f32x4 vq[8]; u32x4 va[2], vb2[2]; bf16x8 af[8]; };
__device__ __forceinline__ void sgu_issue_v(SguV& S, const bf16* Vb, const float* vss, const bf16* Wm, int row0, int g, int tid) {
    const int lane = tid & 63, r32 = lane & 31, hi = lane >> 5; const int wid = __builtin_amdgcn_readfirstlane(tid >> 6), tbk = wid & 3;
    { const f32x4* p = (const f32x4*)(vss + (size_t)(row0 + (tid & 127)) * 32);
#pragma unroll
      for (int i = 0; i < 8; ++i) S.vq[i] = p[i]; }
#pragma unroll
    for (int i = 0; i < 2; ++i) { const int p = tid + 512 * i, sp = p & 63, chk = p >> 6, s = 2 * sp;
        S.va[i] = *(const u32x4*)(Vb + (size_t)(row0 + s) * BR + g * 128 + chk * 8); S.vb2[i] = *(const u32x4*)(Vb + (size_t)(row0 + s + 1) * BR + g * 128 + chk * 8); }
    const bf16* wrow = Wm + (size_t)(g * 128 + 32 * tbk + r32) * 128 + 8 * hi;
#pragma unroll
    for (int c = 0; c < 8; ++c) S.af[c] = *(const bf16x8*)(wrow + 16 * c);
}
__device__ __forceinline__ void sgu_phase(LAS unsigned char* lds, const bf16* Ub, bf16* Ob, const bf16* Vb, const bf16* Gb, const float* vss, const bf16* Wm, const float* vgain, const float* bs, int vcu, int G, int wave_s) {
    int tid_l = my_tid(wave_s); const int tid = tid_l, lane = tid & 63, r32 = lane & 31, hi = lane >> 5;
    const int wid = __builtin_amdgcn_readfirstlane(tid >> 6), tbk = wid & 3, cw = wid >> 2;
    LAS float* rs = (LAS float*)lds; LAS unsigned char* vT = lds + 512;
    LAS float* yl = (LAS float*)(lds + 36864);
    SguV N;
    if (vcu < 2048) sgu_issue_v(N, Vb, vss, Wm, (vcu >> 4) * 128, vcu & 15, tid);
#pragma unroll 1
    for (int u = vcu; u < 2048; u += G) {
        const int row0 = (u >> 4) * 128, g = u & 15;
        SguV C = N;
        u32x4 uv[4]; float gn[2], bsv[16];
#pragma unroll
        for (int i = 0; i < 4; ++i) { const int p = tid + 512 * i, row = p >> 4, ck = p & 15; const size_t off = (size_t)(row0 + row) * BR + g * 128 + ck * 8;
            uv[i] = *(const u32x4*)(Ub + off); }
#pragma unroll
        for (int b = 0; b < 2; ++b) gn[b] = vgain[g * 128 + 64 * cw + 32 * b + r32];
#pragma unroll
        for (int r = 0; r < 16; ++r) bsv[r] = bs[g * 128 + 32 * tbk + crow(r, hi)];
        if (tid < 128) { float s = 0.f;
#pragma unroll
            for (int i = 0; i < 8; ++i) s += (C.vq[i][0] + C.vq[i][1]) + (C.vq[i][2] + C.vq[i][3]);
            rs[tid] = 1.0f / sqrtf(s * (1.0f / 2048.0f) + 1e-6f); }
        __syncthreads();
#pragma unroll
        for (int i = 0; i < 2; ++i) { const int p = tid + 512 * i, sp = p & 63, chk = p >> 6, s = 2 * sp;
            const float ra = rs[s], rb = rs[s + 1];
#pragma unroll
            for (int e = 0; e < 4; ++e) { const float a0 = __uint_as_float(C.va[i][e] << 16) * ra, a1 = __uint_as_float(C.va[i][e] & 0xffff0000u) * ra, b0 = __uint_as_float(C.vb2[i][e] << 16) * rb, b1 = __uint_as_float(C.vb2[i][e] & 0xffff0000u) * rb;
                *(LAS unsigned*)(vT + (chk * 8 + 2 * e) * 272 + s * 2) = pk2(a0, b0); *(LAS unsigned*)(vT + (chk * 8 + 2 * e + 1) * 272 + s * 2) = pk2(a1, b1); } }
        __syncthreads();
        f32x16 acc[2];
#pragma unroll
        for (int b = 0; b < 2; ++b)
#pragma unroll
            for (int r = 0; r < 16; ++r) acc[b][r] = 0.f;
        const LAS unsigned char* vbp = vT + (64 * cw + r32) * 272 + hi * 16;
#pragma unroll
        for (int c = 0; c < 8; ++c) if (c <= 2 * tbk + 1) {
#pragma unroll
            for (int b = 0; b < 2; ++b) { const bf16x8 bfr = *(const LAS bf16x8*)(vbp + b * 32 * 272 + c * 32); acc[b] = MFMA32(C.af[c], bfr, acc[b]); } }
#pragma unroll
        for (int b = 0; b < 2; ++b) { const int chl = 64 * cw + 32 * b + r32;
#pragma unroll
            for (int r = 0; r < 16; ++r) { const int t = 32 * tbk + crow(r, hi); yl[t * 132 + chl] = acc[b][r] * gn[b] + bsv[r]; } }
        if (u + G < 2048) sgu_issue_v(N, Vb, vss, Wm, ((u + G) >> 4) * 128, (u + G) & 15, tid);
        __syncthreads();
#pragma unroll
        for (int i = 0; i < 4; ++i) { const int p = tid + 512 * i, row = p >> 4, ck = p & 15; const size_t off = (size_t)(row0 + row) * BR + g * 128 + ck * 8;
            const f32x4 y0 = *(const LAS f32x4*)(yl + row * 132 + ck * 8), y1 = *(const LAS f32x4*)(yl + row * 132 + ck * 8 + 4); u32x4 w;
#pragma unroll
            for (int e = 0; e < 4; ++e) { const float u0 = __uint_as_float(uv[i][e] << 16), u1 = __uint_as_float(uv[i][e] & 0xffff0000u);
                const float ya = e < 2 ? y0[2 * e] : y1[2 * e - 4], yb = e < 2 ? y0[2 * e + 1] : y1[2 * e - 3];
                w[e] = pk2(ya * u0, yb * u1); }
            *(u32x4*)(Ob + off) = w; }
        asm volatile("s_waitcnt lgkmcnt(0)" ::: "memory"); __builtin_amdgcn_s_barrier(); asm volatile("" ::: "memory");
    }
}
#define XB_TMO      128
#define XB_XCNT(j)  (256  + 64 * (j))
#define XB_XSUB(j)  (1280 + 64 * (j))
#define XB_XGEN(j)  (2304 + 64 * (j))
#define XB_TOP      3328
#define XB_TOPGEN   3392
#define XCD_BAR_WORDS 3456
#define XB_SPIN_CAP (1u << 18)

__device__ __forceinline__ unsigned xb_ld(unsigned* p)              { return __hip_atomic_load(p, __ATOMIC_RELAXED, __HIP_MEMORY_SCOPE_AGENT); }
__device__ __forceinline__ unsigned xb_add(unsigned* p, unsigned v) { return __hip_atomic_fetch_add(p, v, __ATOMIC_RELAXED, __HIP_MEMORY_SCOPE_AGENT); }
__device__ __forceinline__ unsigned xb_xcc_id() { return (unsigned)__builtin_amdgcn_s_getreg((3 << 11) | 20) & 0xFu; }
#define XB_SPIN(cond, bar) do { unsigned _sp = 0; while (cond) { __builtin_amdgcn_s_sleep(1); \
    if ((++_sp & 255u) == 0u) { if (xb_ld(&(bar)[XB_TMO])) break; if (_sp > XB_SPIN_CAP) { atomicAdd(&(bar)[XB_TMO], 1u); break; } } } } while (0)

struct XcdBarrier {
    unsigned* bar; unsigned x;
    volatile LAS unsigned* st;
};

__device__ __forceinline__ XcdBarrier xcd_barrier_post(unsigned* bar, volatile LAS unsigned* st, int tid_) {
    XcdBarrier b; b.bar = bar; b.x = xb_xcc_id(); b.st = st;
    if (tid_ == 0) (void)xb_add(&bar[XB_XCNT(b.x)], 1u);
    return b;
}
__device__ __forceinline__ void xcd_barrier_complete(unsigned* bar, unsigned x, unsigned& nloc, unsigned& nx) {
    const unsigned G = gridDim.x * gridDim.y * gridDim.z;
    unsigned sum, cnt, mine, sp = 0u;
    for (;;) {
        sum = 0u; cnt = 0u; mine = 0u;
#pragma unroll
        for (unsigned j = 0; j < 16; ++j) { const unsigned c = xb_ld(&bar[XB_XCNT(j)]); sum += c; cnt += (c > 0u) ? 1u : 0u; mine = (j == x) ? c : mine; }
        if (sum == G) break;
        __builtin_amdgcn_s_sleep(1);
        if ((++sp & 255u) == 0u) { if (xb_ld(&bar[XB_TMO])) break; if (sp > XB_SPIN_CAP) { atomicAdd(&bar[XB_TMO], 1u); break; } }
    }
    nloc = mine > 0u ? mine : 1u; nx = cnt > 0u ? cnt : 1u;
}

__device__ __forceinline__ void xcd_barrier(const XcdBarrier& b, int tid_) {
    asm volatile("s_waitcnt vmcnt(0)" ::: "memory");
    __syncthreads();
    if (tid_ == 0) {
        unsigned* bar = b.bar;
        __builtin_amdgcn_s_waitcnt(0);
        unsigned nloc = b.st[0], nx = b.st[1];
        if (nloc == 0u) { xcd_barrier_complete(bar, b.x, nloc, nx); b.st[0] = nloc; b.st[1] = nx; }
        const unsigned old = xb_add(&bar[XB_XSUB(b.x)], 1u);
        const unsigned gen = old / nloc;
        if (old + 1u == (gen + 1u) * nloc) {
            __builtin_amdgcn_fence(__ATOMIC_RELEASE, "agent");
            asm volatile("s_waitcnt vmcnt(0)" ::: "memory");
            const unsigned og = xb_add(&bar[XB_TOP], 1u);
            const unsigned tg = og / nx;
            if (og + 1u == (tg + 1u) * nx) xb_add(&bar[XB_TOPGEN], 1u);
            else XB_SPIN(xb_ld(&bar[XB_TOPGEN]) == tg, bar);
            __builtin_amdgcn_fence(__ATOMIC_ACQUIRE, "agent");
            xb_add(&bar[XB_XGEN(b.x)], 1u);
            asm volatile("s_waitcnt vmcnt(0)" ::: "memory");
        } else {
            XB_SPIN(xb_ld(&bar[XB_XGEN(b.x)]) == gen, bar);
            __builtin_amdgcn_fence(__ATOMIC_ACQUIRE, "agent");
            asm volatile("s_waitcnt vmcnt(0)" ::: "memory");
        }
    }
    __syncthreads();
}
__global__ void __launch_bounds__(512, 2) mega_fwd(Args a) {
    extern __shared__ __attribute__((aligned(16))) unsigned char lds_raw[];
    LAS unsigned char* lds = (LAS unsigned char*)lds_raw;
    cg::grid_group grid = cg::this_grid();
    volatile LAS unsigned* MISC = (volatile LAS unsigned*)(lds + RING_BYTES + 320);
    const int wave_s = __builtin_amdgcn_readfirstlane(threadIdx.x >> 6);
    { const int t0 = my_tid(wave_s); if (t0 < 32) MISC[t0] = 0u; }
    __syncthreads();
    XcdBarrier bar = xcd_barrier_post((unsigned*)a.ws, MISC + 8, my_tid(wave_s));
    const int G = gridDim.x, bx = blockIdx.x, vcu = (G % 8 == 0) ? (bx % 8) * (G / 8) + bx / 8 : bx;
    unsigned char* ws = a.ws;
    bf16* xb = (bf16*)(ws + WS_XB); float* rowss = (float*)(ws + WS_ROWSS); float* vss = (float*)(ws + WS_VSS);
    bf16* act = (bf16*)(ws + WS_ACT); bf16* wbase = (bf16*)(ws + WS_W);
    bf16* ybuf = (bf16*)(ws + WS_END);
    for (int ph = a.ph_lo; ph < a.ph_hi; ++ph) {
        int tid_l = my_tid(wave_s); const int tid = tid_l, lane = tid & 63, wave = __builtin_amdgcn_readfirstlane(tid >> 6);
        if (ph == 0) prologue(a, lds, vcu, G, wave_s);
        else if (ph == NPHASE - 1) {
            const float* gf = a.in[16];
            for (int m = vcu * 8 + wave; m < MTOK; m += G * 8) { const u32x2* xr = (const u32x2*)(xb + (size_t)m * DM) + lane; f32x4 v[4]; float s = 0.f;
#pragma unroll
                for (int j = 0; j < 4; ++j) { const u32x2 w = xr[64 * j]; v[j][0] = __uint_as_float(w.x << 16); v[j][1] = __uint_as_float(w.x & 0xffff0000u); v[j][2] = __uint_as_float(w.y << 16); v[j][3] = __uint_as_float(w.y & 0xffff0000u);
                    s += (v[j][0] * v[j][0] + v[j][1] * v[j][1]) + (v[j][2] * v[j][2] + v[j][3] * v[j][3]); }
                const float rstd = 1.0f / sqrtf(wave_sum(s) * (1.0f / DM) + 1e-6f);
                f32x4* orow = (f32x4*)(a.out + (size_t)m * DM) + lane;
#pragma unroll
                for (int j = 0; j < 4; ++j) { const f32x4 gg = *((const f32x4*)gf + lane + 64 * j); orow[64 * j] = v[j] * rstd * gg; } }
        } else {
            const int q8p = (ph - 2) >> 1; const bool odd = (ph & 1) != 0;
            const int nsub = (ph > 1 && odd && q8p < 7) ? 2 : 1;
            for (int sub = 0; sub < nsub; ++sub) {
            const int st = (ph == 1) ? 0 : (!odd ? 1 : (sub == 0 ? 2 : 0));
            const int q8 = (ph == 1) ? 0 : q8p + (sub == 1 ? 1 : 0);
            const int L = q8 >> 1, hb = q8 & 1, j = L >> 1; const bool is_attn = (L & 1) == 0;
            const bf16* xbh = xb + (size_t)hb * HTOK * DM; const float* rssh = (const float*)(ws + WS_RSTD) + (size_t)hb * HTOK;
            if (st == 0) {
                const bf16* wt = is_attn ? wbase + (W_ATT_IN + (size_t)j * 16 * MiB) / 2 : wbase + (W_SGU_IN + (size_t)j * 12 * MiB) / 2;
                { pg8::Gemm g{xbh, wt, HTOK, 6144, DM}; pg8::StaticOrder S; S.init(HTOK, 6144, G, bx);
                  pg8::EpiIn E{act, BR, BR, ACT_STRIDE, QSCALE, is_attn ? 8 : 0, rssh, vss, is_attn ? 0 : 16, is_attn ? 0 : 24, is_attn ? 0 : 16};
                  pg8::gemm_phase<pg8::EpiIn, pg8::StaticOrder, true, true>(lds, g, S, E, wave_s); }
                if (is_attn) { pg8::Gemm g{wt + (size_t)6144 * DM, xbh, BR, HTOK, DM}; pg8::StaticOrder S; S.init(BR, HTOK, G, bx);
                  pg8::EpiVT E{act + 3 * ACT_STRIDE, HTOK, rssh};
                  pg8::gemm_phase<pg8::EpiVT, pg8::StaticOrder, true, true>(lds, g, S, E, wave_s); }
            } else if (st == 1) {
                if ((hb == 1 || L > 0) && tid < 64) {
                    for (int r_ = bx * 64 + tid; r_ < HTOK; r_ += G * 64) { const int row = (1 - hb) * HTOK + r_; ((float*)(ws + WS_RSTD))[row] = pg8::rstd16(rowss + (size_t)row * 16); } }
                if (is_attn) {
                    const float lam_init = (L == 0) ? 0.2f : 0.47071302f;
                    const float d1 = wave_sum(a.in[4][j * 64 + lane] * a.in[5][j * 64 + lane]), d2 = wave_sum(a.in[6][j * 64 + lane] * a.in[7][j * 64 + lane]);
                    const float lam = expf(d1) - expf(d2) + lam_init;
                    if (PROBE_DUP == 1) { bf16* yb2 = ybuf;
                      for (int p = vcu; p < 1024; p += G) { const int bh = p >> 4, s = p & 15;
                        attn_unit<PROBE_ABL>(lds, act, yb2, act + ACT_STRIDE, act + 2 * ACT_STRIDE, act + 3 * ACT_STRIDE, a.in[1], a.in[8] + j * 128, lam, 1.0f - lam_init, bh >> 4, bh & 15, 31 - s, wave_s);
                        attn_unit<PROBE_ABL>(lds, act, yb2, act + ACT_STRIDE, act + 2 * ACT_STRIDE, act + 3 * ACT_STRIDE, a.in[1], a.in[8] + j * 128, lam, 1.0f - lam_init, bh >> 4, bh & 15, s, wave_s); } }
                    for (int p = vcu; p < 1024; p += G) { const int bh = p >> 4, s = p & 15;
                        attn_unit<0>(lds, act, ybuf, act + ACT_STRIDE, act + 2 * ACT_STRIDE, act + 3 * ACT_STRIDE, a.in[1], a.in[8] + j * 128, lam, 1.0f - lam_init, bh >> 4, bh & 15, 31 - s, wave_s);
                        attn_unit<0>(lds, act, ybuf, act + ACT_STRIDE, act + 2 * ACT_STRIDE, act + 3 * ACT_STRIDE, a.in[1], a.in[8] + j * 128, lam, 1.0f - lam_init, bh >> 4, bh & 15, s, wave_s); }
                } else {
                    const bf16* wm = (const bf16*)(ws + WS_WM) + (size_t)j * 16 * 128 * 128;
                    sgu_phase(lds, act, ybuf, act + ACT_STRIDE, act + 2 * ACT_STRIDE, vss, wm, a.in[12] + j * BR, a.in[14] + j * 16 * 128, vcu, G, wave_s);
                }
            } else {
                const bf16* wt = is_attn ? wbase + (W_ATT_OUT + (size_t)j * 4 * MiB) / 2 : wbase + (W_SGU_OUT + (size_t)j * 4 * MiB) / 2;
                pg8::Gemm g{ybuf, wt, HTOK, DM, BR}; pg8::StaticOrder S; S.init(HTOK, DM, G, bx);
                pg8::EpiOut E{L == 0 ? a.in[0] : nullptr, xb, rowss, hb * HTOK};
                pg8::gemm_phase<pg8::EpiOut, pg8::StaticOrder, true, true>(lds, g, S, E, wave_s);
            }
            }
        }
        if (ph + 1 < a.ph_hi) { if (ph == 0 && a.pad0 != 0) grid.sync(); else xcd_barrier(bar, my_tid(wave_s)); }
    }
}

extern "C" void kernel_launch(void* const* d_in, const int* in_sizes, int n_in, void* d_out, int out_size, void* d_ws, size_t ws_size, hipStream_t stream) {
    static int grid = 0;
    if (grid == 0) {
        if (n_in != 17 || out_size != MTOK * DM || ws_size < WS_END + 64 * MiB) { fprintf(stderr, "kernel_launch: unexpected shapes: n_in %d out %d ws %zu\n", n_in, out_size, ws_size); grid = -1; return; }
        int dev = 0, cus = 0, per_cu = 0;
        hipGetDevice(&dev); hipDeviceGetAttribute(&cus, hipDeviceAttributeMultiprocessorCount, dev);
        if (hipFuncSetAttribute((const void*)mega_fwd, hipFuncAttributeMaxDynamicSharedMemorySize, LDS_BYTES) != hipSuccess) { fprintf(stderr, "kernel_launch: hipFuncSetAttribute failed\n"); grid = -1; return; }
        if (hipOccupancyMaxActiveBlocksPerMultiprocessor(&per_cu, (const void*)mega_fwd, 512, LDS_BYTES) != hipSuccess || per_cu < 1) { fprintf(stderr, "kernel_launch: occupancy query gives %d\n", per_cu); per_cu = 1; }
        (void)hipGetLastError();
        grid = cus * per_cu; if (grid > 256) grid = 256;
        fprintf(stderr, "kernel_launch: grid %d (cus %d per_cu %d) ws %zu\n", grid, cus, per_cu, ws_size);
    }
    if (grid < 0) return;
    if (hipMemsetAsync(d_ws, 0, 65536, stream) != hipSuccess) { fprintf(stderr, "kernel_launch: memset failed\n"); return; }
    Args a{};
    for (int i = 0; i < 17; ++i) a.in[i] = (const float*)d_in[i];
    a.out = (float*)d_out; a.ws = (unsigned char*)d_ws;
#if ONE_LAUNCH
    a.ph_lo = 0; a.ph_hi = NPHASE;
    void* kargs[] = {&a};
    hipError_t e = hipLaunchCooperativeKernel((const void*)mega_fwd, dim3(grid), dim3(512), kargs, LDS_BYTES, stream);
    if (e != hipSuccess) fprintf(stderr, "kernel_launch: cooperative launch failed: %s (grid %d)\n", hipGetErrorString(e), grid);
#else
    for (int ph = 0; ph < NPHASE; ++ph) { a.ph_lo = ph; a.ph_hi = ph + 1; hipLaunchKernelGGL(mega_fwd, dim3(grid), dim3(512), LDS_BYTES, stream, a); }
#endif
}
```

```cpp
#include <hip/hip_runtime.h>
#include <hip/hip_cooperative_groups.h>
#include <cstdio>
#include <cstdint>
namespace cg = cooperative_groups;
#ifndef ONE_LAUNCH
#define ONE_LAUNCH 1
#endif
#ifndef PROBE_DUP
#define PROBE_DUP 0
#endif
#ifndef PROBE_ABL
#define PROBE_ABL 0
#endif
__device__ __forceinline__ int my_tid(int wave_s) { int l; asm volatile("v_mbcnt_lo_u32_b32 %0, -1, 0\n\tv_mbcnt_hi_u32_b32 %0, -1, %0" : "=v"(l)); return wave_s * 64 + l; }
namespace pg8 {
#define PG8_LAS __attribute__((address_space(3)))
typedef unsigned short bf16_t;
typedef short bf16x8 __attribute__((ext_vector_type(8)));
typedef float f32x4 __attribute__((ext_vector_type(4)));
typedef unsigned u32x4 __attribute__((ext_vector_type(4)));
constexpr int BM = 256, BK = 64, HALF = 128, HTB = HALF * BK * 2  , STAGE_BYTES = 8 * HTB, NXCD = 8, WGM = 8;

__host__ __device__ __forceinline__ int lds_byte(int r, int c) { const int st = (r >> 4) * 2 + (c >> 5), rr = r & 15, cc = c & 31, ob = rr * 64 + cc * 2; return st * 1024 + (ob ^ (((ob >> 9) & 1) << 5)); }
__host__ __device__ __forceinline__ void stage_rc(int b, int& R, int& C) { const int st = b / 1024, sb = b % 1024, swz = sb ^ (((sb >> 9) & 1) << 5); R = (st >> 1) * 16 + swz / 64; C = (st & 1) * 32 + (swz % 64) / 2; }
__host__ __device__ __forceinline__ int perm32(int rho) { const int n = rho >> 4, i = rho & 15; return 8 * (i >> 2) + 4 * n + (i & 3); }

struct Unit { int pm, pn; };
struct Gemm { const bf16_t* A; const bf16_t* Bt; int M, N, K; };

struct StaticOrder {
    int nM, nN, nwg, G, c;
    __host__ __device__ void init(int M, int N, int G_, int c_) { nM = M / BM; nN = N / BM; nwg = nM * nN; G = G_; c = c_; }
    __host__ __device__ bool next(int i, Unit& u) const {
        const long L = (long)i * G + c; if (L >= nwg) return false;
        int wgid = (int)L; { const int q = nwg / NXCD, r = nwg % NXCD, xcd = wgid % NXCD, off = wgid / NXCD; wgid = (xcd < r ? xcd * (q + 1) : r * (q + 1) + (xcd - r) * q) + off; }
        const int nig = WGM * nN, gid = wgid / nig, fm = gid * WGM, gsz = (nM - fm) < WGM ? (nM - fm) : WGM;
        u.pm = fm + ((wgid % nig) % gsz); u.pn = (wgid % nig) / gsz; return true;
    }
    __device__ __forceinline__ void a_ready(const Unit&) const {}
    __device__ __forceinline__ void done(const Unit&) const {}
};

__device__ __forceinline__ unsigned cvt_pk_bf16(float lo, float hi) { unsigned r; asm volatile("v_cvt_pk_bf16_f32 %0, %1, %2" : "=v"(r) : "v"(lo), "v"(hi)); return r; }
typedef float f32x2 __attribute__((ext_vector_type(2)));
typedef unsigned u32x2 __attribute__((ext_vector_type(2)));
__device__ __forceinline__ float rstd16(const float* p) {
    const f32x4 a = *(const f32x4*)p, b = *(const f32x4*)(p + 4), c = *(const f32x4*)(p + 8), d = *(const f32x4*)(p + 12);
    const float s = (((a[0] + a[1]) + (a[2] + a[3])) + ((b[0] + b[1]) + (b[2] + b[3]))) + (((c[0] + c[1]) + (c[2] + c[3])) + ((d[0] + d[1]) + (d[2] + d[3])));
    return 1.0f / sqrtf(s * (1.0f / 1024.0f) + 1e-6f);
}
struct EpiIn {
    static constexpr bool PERM = true, AFTER_DRAIN = false;
    bf16_t* O; int ldc; int split_cols; size_t split_stride; float qscale; int q_tiles; const float* rowss; float* vss; int v_lo, v_hi; int ug_tiles;
    __device__ __forceinline__ void operator()(const f32x4 (&acc)[2][2][4][2], const Unit& u, int wr, int wc, int fr, int fq) const {
        const int row0 = u.pm * BM + wr * 64 + fr; int colt = u.pn * BM; bf16_t* base = O;
        if (ug_tiles) {
            if (u.pn < ug_tiles) {
                const int colg = u.pn * HALF + wc * 32 + 8 * fq;
#pragma unroll
                for (int ai = 0; ai < 2; ++ai)
#pragma unroll
                    for (int m = 0; m < 4; ++m) { const int row = row0 + ai * HALF + m * 16; const float sc = rowss[row];
                        const f32x4 u0 = acc[ai][0][m][0] * sc, u1 = acc[ai][0][m][1] * sc, g0 = acc[ai][1][m][0] * sc, g1 = acc[ai][1][m][1] * sc; f32x4 r0, r1;
#pragma unroll
                        for (int e_ = 0; e_ < 4; ++e_) { r0[e_] = u0[e_] * g0[e_] * __builtin_amdgcn_rcpf(1.0f + __builtin_amdgcn_exp2f(-1.4426950408889634f * g0[e_])); r1[e_] = u1[e_] * g1[e_] * __builtin_amdgcn_rcpf(1.0f + __builtin_amdgcn_exp2f(-1.4426950408889634f * g1[e_])); }
                        u32x4 w; w.x = cvt_pk_bf16(r0[0], r0[1]); w.y = cvt_pk_bf16(r0[2], r0[3]); w.z = cvt_pk_bf16(r1[0], r1[1]); w.w = cvt_pk_bf16(r1[2], r1[3]);
                        *(u32x4*)(O + (size_t)row * ldc + colg) = w; }
                return;
            }
            base += split_stride; colt = (u.pn - ug_tiles) * BM;
        } else { const int t = colt / split_cols; base += (size_t)t * split_stride; colt -= t * split_cols; }
        const float qs = (u.pn < q_tiles) ? qscale : 1.f;
        const int col0 = colt + wc * 32 + 8 * fq;
        const bool dov = (u.pn >= v_lo && u.pn < v_hi);
#pragma unroll
        for (int ai = 0; ai < 2; ++ai)
#pragma unroll
            for (int m = 0; m < 4; ++m) {
                const int row = row0 + ai * HALF + m * 16; const float sc = rowss[row] * qs; bf16_t* rowp = base + (size_t)row * ldc + col0; float ss = 0.f;
#pragma unroll
                for (int bj = 0; bj < 2; ++bj) { const f32x4 v0 = acc[ai][bj][m][0] * sc, v1 = acc[ai][bj][m][1] * sc;
                    if (dov) ss += ((v0[0] * v0[0] + v0[1] * v0[1]) + (v0[2] * v0[2] + v0[3] * v0[3])) + ((v1[0] * v1[0] + v1[1] * v1[1]) + (v1[2] * v1[2] + v1[3] * v1[3]));
                    u32x4 w; w.x = cvt_pk_bf16(v0[0], v0[1]); w.y = cvt_pk_bf16(v0[2], v0[3]); w.z = cvt_pk_bf16(v1[0], v1[1]); w.w = cvt_pk_bf16(v1[2], v1[3]);
                    *(u32x4*)(rowp + bj * HALF) = w; }
                if (dov) { ss += __shfl_xor(ss, 16); ss += __shfl_xor(ss, 32); if (fq == 0) vss[(size_t)row * 32 + (u.pn - v_lo) * 4 + wc] = ss; }
            }
    }
};
struct EpiVT {
    static constexpr bool PERM = true, AFTER_DRAIN = false;
    bf16_t* O; int ldc; const float* rowss;
    __device__ __forceinline__ void operator()(const f32x4 (&acc)[2][2][4][2], const Unit& u, int wr, int wc, int fr, int fq) const {
        const int row0 = u.pm * BM + wr * 64 + fr; const int col0 = u.pn * BM + wc * 32 + 8 * fq;
        f32x4 cs[2][2];
#pragma unroll
        for (int bj = 0; bj < 2; ++bj)
#pragma unroll
            for (int n = 0; n < 2; ++n)
                cs[bj][n] = *(const f32x4*)(rowss + col0 + bj * HALF + 4 * n);
#pragma unroll
        for (int ai = 0; ai < 2; ++ai)
#pragma unroll
            for (int m = 0; m < 4; ++m) { bf16_t* rowp = O + (size_t)(row0 + ai * HALF + m * 16) * ldc + col0;
#pragma unroll
                for (int bj = 0; bj < 2; ++bj) { const f32x4 v0 = acc[ai][bj][m][0] * cs[bj][0], v1 = acc[ai][bj][m][1] * cs[bj][1];
                    u32x4 w; w.x = cvt_pk_bf16(v0[0], v0[1]); w.y = cvt_pk_bf16(v0[2], v0[3]); w.z = cvt_pk_bf16(v1[0], v1[1]); w.w = cvt_pk_bf16(v1[2], v1[3]);
                    *(u32x4*)(rowp + bj * HALF) = w; } }
    }
};
struct EpiOut {
    static constexpr bool PERM = true, AFTER_DRAIN = false;
    const float* base32; bf16_t* xb; float* rowss; int row_off;
    __device__ __forceinline__ void operator()(const f32x4 (&acc)[2][2][4][2], const Unit& u, int wr, int wc, int fr, int fq) const {
        const int row0 = row_off + u.pm * BM + wr * 64 + fr; const int col0 = u.pn * BM + wc * 32 + 8 * fq;
#pragma unroll
        for (int ai = 0; ai < 2; ++ai)
#pragma unroll
            for (int m = 0; m < 4; ++m) { const int row = row0 + ai * HALF + m * 16; const size_t off = (size_t)row * 1024 + col0; float ss = 0.f;
#pragma unroll
                for (int bj = 0; bj < 2; ++bj) { const size_t o = off + bj * HALF; f32x4 b0, b1;
                    if (base32) { b0 = *(const f32x4*)(base32 + o); b1 = *(const f32x4*)(base32 + o + 4); }
                    else { const u32x4 w = *(const u32x4*)(xb + o);
                        b0[0] = __uint_as_float(w.x << 16); b0[1] = __uint_as_float(w.x & 0xffff0000u); b0[2] = __uint_as_float(w.y << 16); b0[3] = __uint_as_float(w.y & 0xffff0000u);
                        b1[0] = __uint_as_float(w.z << 16); b1[1] = __uint_as_float(w.z & 0xffff0000u); b1[2] = __uint_as_float(w.w << 16); b1[3] = __uint_as_float(w.w & 0xffff0000u); }
                    const f32x4 x0 = b0 + acc[ai][bj][m][0], x1 = b1 + acc[ai][bj][m][1];
                    ss += ((x0[0] * x0[0] + x0[1] * x0[1]) + (x0[2] * x0[2] + x0[3] * x0[3])) + ((x1[0] * x1[0] + x1[1] * x1[1]) + (x1[2] * x1[2] + x1[3] * x1[3]));
                    u32x4 w2; w2.x = cvt_pk_bf16(x0[0], x0[1]); w2.y = cvt_pk_bf16(x0[2], x0[3]); w2.z = cvt_pk_bf16(x1[0], x1[1]); w2.w = cvt_pk_bf16(x1[2], x1[3]);
                    *(u32x4*)(xb + o) = w2; }
                ss += __shfl_xor(ss, 16); ss += __shfl_xor(ss, 32); if (fq == 0) rowss[(size_t)row * 16 + u.pn * 4 + wc] = ss; }
    }
};
template <class Epi, class Sched, bool ALIGN_EPI = false, bool SP2 = false>
__device__ __forceinline__ void gemm_phase(PG8_LAS unsigned char* lds, const Gemm g, const Sched& S, const Epi& E, int wave_s) {
    int tid_l = my_tid(wave_s); const int tid = tid_l, wid = __builtin_amdgcn_readfirstlane(tid >> 6), lane = tid & 63, wr = wid >> 2, wc = wid & 3, fr = lane & 15, fq = lane >> 4;
    const int K = g.K, nt = K / BK;
    unsigned voffA[2], voffB[2];
#pragma unroll
    for (int i = 0; i < 2; ++i) { int R, C; stage_rc(tid * 16 + i * 8192, R, C); const int Rb = Epi::PERM ? ((R & ~31) + perm32(R & 31)) : R;
        voffA[i] = (unsigned)(R * K + C) * 2u; voffB[i] = (unsigned)(Rb * K + C) * 2u; }
    const size_t kstep = (size_t)(BK * 2);
    const size_t hstep = (size_t)HALF * K * 2;
    const size_t tstep = 2 * hstep;
    const unsigned ldsw = (unsigned)wid * 1024u;
    const int aoff = lds_byte(wr * 64 + fr, fq * 8), boff = lds_byte(wc * 32 + fr, fq * 8);
#define PG8_SA(b, h) (((b) * 2 + (h)) * HTB)
#define PG8_SB(b, h) ((4 + (b) * 2 + (h)) * HTB)
    const unsigned ldsb = (unsigned)(uintptr_t)lds + ldsw;
#define PG8_STAGE(bufoff, gbase, voff) do { _Pragma("unroll") for (int _i = 0; _i < 2; ++_i) { unsigned keep_; \
        asm volatile("s_mov_b32 %0, m0\n\ts_mov_b32 m0, %3\n\ts_nop 0\n\tglobal_load_lds_dwordx4 %1, %2\n\ts_mov_b32 m0, %0" : "=&s"(keep_) : "v"((voff)[_i]), "s"((const char*)(gbase)), "s"(ldsb + (unsigned)((bufoff) + _i * 8192)) : "memory"); } } while (0)
#define PG8_LDA(dst, b, h) do { _Pragma("unroll") for (int m = 0; m < 4; ++m) _Pragma("unroll") for (int k = 0; k < 2; ++k) dst[m][k] = *(const PG8_LAS bf16x8*)(lds + PG8_SA(b, h) + aoff + m * 2048 + k * 1024); } while (0)
#define PG8_LDB(dst, b, h) do { _Pragma("unroll") for (int n = 0; n < 2; ++n) _Pragma("unroll") for (int k = 0; k < 2; ++k) dst[n][k] = *(const PG8_LAS bf16x8*)(lds + PG8_SB(b, h) + boff + n * 2048 + k * 1024); } while (0)
#define PG8_MMA(ai, bj, At, Bt) do { __builtin_amdgcn_s_setprio(1); _Pragma("unroll") for (int m = 0; m < 4; ++m) _Pragma("unroll") for (int n = 0; n < 2; ++n) _Pragma("unroll") for (int k = 0; k < 2; ++k) \
        acc[ai][bj][m][n] = __builtin_amdgcn_mfma_f32_16x16x32_bf16(Bt[n][k], At[m][k], acc[ai][bj][m][n], 0, 0, 0); __builtin_amdgcn_s_setprio(0); } while (0)
#define PG8_WAIT_V(n) asm volatile("s_waitcnt vmcnt(" #n ")" ::: "memory")
#define PG8_WAIT_L(n) asm volatile("s_waitcnt lgkmcnt(" #n ")" ::: "memory")
#define PG8_BAR __builtin_amdgcn_s_barrier()
#define PG8_SCHED __builtin_amdgcn_sched_barrier(0)
    Unit cur, nxt; int ui = 0;
    if (!S.next(0, cur)) return;
    f32x4 acc[2][2][4][2];
#pragma unroll
    for (int a = 0; a < 2; ++a)
#pragma unroll
        for (int b = 0; b < 2; ++b)
#pragma unroll
            for (int m = 0; m < 4; ++m)
#pragma unroll
                for (int n = 0; n < 2; ++n) acc[a][b][m][n] = (f32x4){0.f, 0.f, 0.f, 0.f};
    bf16x8 At[4][2], B0[2][2], B1[2][2];
    const char* cA = (const char*)g.A + (size_t)cur.pm * tstep; const char* cB = (const char*)g.Bt + (size_t)cur.pn * tstep;
    S.a_ready(cur);
    if constexpr (SP2) {
        PG8_STAGE(PG8_SB(0, 0), cB, voffB); PG8_STAGE(PG8_SB(0, 1), cB + hstep, voffB); PG8_STAGE(PG8_SA(0, 0), cA, voffA); PG8_STAGE(PG8_SA(0, 1), cA + hstep, voffA);
        if (wr == 1) PG8_BAR;
        PG8_WAIT_V(2); PG8_BAR;
        PG8_STAGE(PG8_SB(1, 0), cB + kstep, voffB); PG8_STAGE(PG8_SA(1, 0), cA + kstep, voffA); PG8_STAGE(PG8_SB(1, 1), cB + hstep + kstep, voffB);
        PG8_WAIT_V(6); PG8_BAR;
    } else {
        PG8_STAGE(PG8_SB(0, 0), cB, voffB); PG8_STAGE(PG8_SA(0, 0), cA, voffA); PG8_STAGE(PG8_SB(0, 1), cB + hstep, voffB); PG8_STAGE(PG8_SA(0, 1), cA + hstep, voffA);
        if (wr == 1) PG8_BAR;
        PG8_WAIT_V(4); PG8_BAR;
        PG8_STAGE(PG8_SB(1, 0), cB + kstep, voffB); PG8_STAGE(PG8_SA(1, 0), cA + kstep, voffA); PG8_STAGE(PG8_SB(1, 1), cB + hstep + kstep, voffB);
        PG8_WAIT_V(6); PG8_BAR;
    }
    for (;;) {
        const bool has_next = S.next(ui + 1, nxt);
        const char* nA = has_next ? (const char*)g.A + (size_t)nxt.pm * tstep : cA; const char* nB = has_next ? (const char*)g.Bt + (size_t)nxt.pn * tstep : cB;
        for (int t = 0; t < nt; t += 2) {
            const bool last = (t == nt - 2);
            const char* a1 = cA + (size_t)(t + 1) * kstep;
            const char* a2 = last ? nA : cA + (size_t)(t + 2) * kstep; const char* b2 = last ? nB : cB + (size_t)(t + 2) * kstep;
            const char* a3 = a2 + kstep; const char* b3 = b2 + kstep;
            if (last && has_next) S.a_ready(nxt);
            if constexpr (SP2) {
            PG8_LDB(B0, 0, 0); PG8_LDB(B1, 0, 1); PG8_SCHED; PG8_LDA(At, 0, 0); PG8_STAGE(PG8_SA(1, 1), a1 + hstep, voffA);
            PG8_WAIT_V(8); PG8_WAIT_L(0); PG8_BAR; PG8_MMA(0, 0, At, B0); PG8_MMA(0, 1, At, B1); PG8_BAR; PG8_SCHED;
            PG8_LDA(At, 0, 1); PG8_STAGE(PG8_SB(0, 0), b2, voffB); PG8_STAGE(PG8_SB(0, 1), b2 + hstep, voffB); PG8_STAGE(PG8_SA(0, 0), a2, voffA);
            PG8_WAIT_V(8); PG8_WAIT_L(0); PG8_BAR; PG8_MMA(1, 0, At, B0); PG8_MMA(1, 1, At, B1); PG8_BAR; PG8_SCHED;
            PG8_LDB(B0, 1, 0); PG8_LDB(B1, 1, 1); PG8_SCHED; PG8_LDA(At, 1, 0); PG8_STAGE(PG8_SA(0, 1), a2 + hstep, voffA);
            PG8_WAIT_V(8); PG8_WAIT_L(0); PG8_BAR; PG8_MMA(0, 0, At, B0); PG8_MMA(0, 1, At, B1); PG8_BAR; PG8_SCHED;
            PG8_LDA(At, 1, 1); PG8_STAGE(PG8_SB(1, 0), b3, voffB); PG8_STAGE(PG8_SB(1, 1), b3 + hstep, voffB); PG8_STAGE(PG8_SA(1, 0), a3, voffA);
            PG8_WAIT_V(8); PG8_WAIT_L(0); PG8_BAR; PG8_MMA(1, 0, At, B0); PG8_MMA(1, 1, At, B1); PG8_BAR; PG8_SCHED;
            } else {
            PG8_LDB(B0, 0, 0); PG8_SCHED; PG8_LDA(At, 0, 0); PG8_STAGE(PG8_SA(1, 1), a1 + hstep, voffA);
            PG8_WAIT_L(8); PG8_BAR; PG8_WAIT_L(0); PG8_MMA(0, 0, At, B0); PG8_BAR; PG8_SCHED;
            PG8_LDB(B1, 0, 1); PG8_STAGE(PG8_SB(0, 0), b2, voffB);
            PG8_BAR; PG8_WAIT_L(0); PG8_MMA(0, 1, At, B1); PG8_BAR;
            PG8_LDA(At, 0, 1); PG8_STAGE(PG8_SA(0, 0), a2, voffA);
            PG8_BAR; PG8_WAIT_L(0); PG8_MMA(1, 0, At, B0); PG8_BAR; PG8_SCHED;
            PG8_STAGE(PG8_SB(0, 1), b2 + hstep, voffB);
            PG8_WAIT_V(6); PG8_BAR; PG8_MMA(1, 1, At, B1); PG8_BAR;
            PG8_LDB(B0, 1, 0); PG8_SCHED; PG8_LDA(At, 1, 0); PG8_STAGE(PG8_SA(0, 1), a2 + hstep, voffA);
            PG8_WAIT_L(8); PG8_BAR; PG8_WAIT_L(0); PG8_MMA(0, 0, At, B0); PG8_BAR; PG8_SCHED;
            PG8_LDB(B1, 1, 1); PG8_STAGE(PG8_SB(1, 0), b3, voffB);
            PG8_BAR; PG8_WAIT_L(0); PG8_MMA(0, 1, At, B1); PG8_BAR;
            PG8_LDA(At, 1, 1); PG8_STAGE(PG8_SA(1, 0), a3, voffA);
            PG8_BAR; PG8_WAIT_L(0); PG8_MMA(1, 0, At, B0); PG8_BAR; PG8_SCHED;
            PG8_STAGE(PG8_SB(1, 1), b3 + hstep, voffB);
            PG8_WAIT_V(6); PG8_BAR; PG8_MMA(1, 1, At, B1); PG8_BAR;
            }
        }
        if constexpr (ALIGN_EPI) { if (wr == 0) PG8_BAR; }
        if constexpr (!Epi::AFTER_DRAIN) { E(acc, cur, wr, wc, fr, fq); S.done(cur); }
        if (!has_next) break;
#pragma unroll
        for (int a = 0; a < 2; ++a)
#pragma unroll
            for (int b = 0; b < 2; ++b)
#pragma unroll
                for (int m = 0; m < 4; ++m)
#pragma unroll
                    for (int n = 0; n < 2; ++n) acc[a][b][m][n] = (f32x4){0.f, 0.f, 0.f, 0.f};
        cur = nxt; cA = nA; cB = nB; ++ui;
        if constexpr (ALIGN_EPI) { if (wr == 1) PG8_BAR; }
    }
    PG8_WAIT_V(0);
    if constexpr (!ALIGN_EPI) { if (wr == 0) PG8_BAR; }
    PG8_BAR;
    if constexpr (Epi::AFTER_DRAIN) { E.fused(acc, cur, wr, wc, fr, fq, lds, wid, lane); S.done(cur); }
#undef PG8_SA
#undef PG8_SB
#undef PG8_STAGE
#undef PG8_LDA
#undef PG8_LDB
#undef PG8_MMA
#undef PG8_WAIT_V
#undef PG8_WAIT_L
#undef PG8_BAR
#undef PG8_SCHED
}
}
#define LAS __attribute__((address_space(3)))
typedef unsigned short bf16;
typedef short bf16x8 __attribute__((ext_vector_type(8)));
typedef float f32x16 __attribute__((ext_vector_type(16)));
typedef float f32x4 __attribute__((ext_vector_type(4)));
typedef unsigned u32x4 __attribute__((ext_vector_type(4)));
typedef unsigned u32x2 __attribute__((ext_vector_type(2)));
typedef float f32x2_t __attribute__((ext_vector_type(2))); typedef __bf16 bf16x2_t __attribute__((ext_vector_type(2)));
constexpr int DM = 1024, SEQ = 4096, MTOK = 32768, HTOK = 16384, BR = 2048, NHEAD = 16;
constexpr size_t MiB = 1u << 20;
constexpr size_t WS_ROWSS = 1 * MiB;
constexpr size_t WS_VSS = 3 * MiB;
constexpr size_t WS_RSTD = 6 * MiB;
constexpr size_t WS_WM = 5 * MiB;
constexpr size_t WS_W = 8 * MiB;
constexpr size_t W_ATT_IN = 0, W_ATT_OUT = 32 * MiB, W_SGU_IN = 40 * MiB, W_SGU_OUT = 64 * MiB;
constexpr size_t WS_XB = 80 * MiB;
constexpr size_t WS_ACT = 144 * MiB;
constexpr size_t ACT_STRIDE = (size_t)HTOK * BR;
constexpr size_t WS_END = 400 * MiB;
constexpr int RING_BYTES = 131072, LDS_BYTES = 147456;
constexpr float LOG2E = 1.4426950408889634f;
constexpr float QSCALE = 0.125f * LOG2E;
constexpr int NPHASE = 19;

__device__ __forceinline__ float bf2f(unsigned short b) { return __uint_as_float((unsigned)b << 16); }
__device__ __forceinline__ unsigned pk2(float lo, float hi) { f32x2_t v = {lo, hi}; bf16x2_t b = __builtin_convertvector(v, bf16x2_t); return __builtin_bit_cast(unsigned, b); }
__device__ __forceinline__ float wave_sum(float v) {
#pragma unroll
    for (int o = 1; o < 64; o <<= 1) v += __shfl_xor(v, o);
    return v;
}
__device__ __forceinline__ float swap_max(float m) { auto rr = __builtin_amdgcn_permlane32_swap(__float_as_uint(m), __float_as_uint(m), false, false); return fmaxf(__uint_as_float(rr[0]), __uint_as_float(rr[1])); }
__device__ __forceinline__ float swap_sum(float m) { auto rr = __builtin_amdgcn_permlane32_swap(__float_as_uint(m), __float_as_uint(m), false, false); return __uint_as_float(rr[0]) + __uint_as_float(rr[1]); }
__device__ __forceinline__ float silu_f(float x) { return x * __builtin_amdgcn_rcpf(1.0f + __builtin_amdgcn_exp2f(-LOG2E * x)); }
__device__ __forceinline__ int crow(int r, int hi) { return (r & 3) + 8 * (r >> 2) + 4 * hi; }
__device__ __forceinline__ float fadd_s(float a, float b) { float r; asm("v_add_f32_e32 %0, %1, %2" : "=v"(r) : "v"(a), "v"(b)); return r; }
__device__ __forceinline__ float max3f_s(float a, float b, float c) { float r; asm("v_max3_f32 %0, %1, %2, %3" : "=v"(r) : "v"(a), "v"(b), "v"(c)); return r; }
__device__ __forceinline__ float max2f_s(float a, float b) { float r; asm("v_max_f32_e32 %0, %1, %2" : "=v"(r) : "v"(a), "v"(b)); return r; }
#define MFMA32(a, b, c) __builtin_amdgcn_mfma_f32_32x32x16_bf16((a), (b), (c), 0, 0, 0)

struct Args { const float* in[17]; float* out; unsigned char* ws; int ph_lo, ph_hi, pad0, pad1; };

__device__ __forceinline__ void transpose_item(const float* W, const float* gain, int K, int N, bf16* WT, int n0, int dst_row0, int k0, LAS float* scr, int lane) {
#pragma unroll
    for (int i = 0; i < 32; ++i) { const int kk = 2 * i + (lane >> 5); const float gv = gain ? gain[k0 + kk] : 1.f; scr[kk * 33 + (lane & 31)] = W[(size_t)(k0 + kk) * N + n0 + (lane & 31)] * gv; }
    asm volatile("s_waitcnt lgkmcnt(0)" ::: "memory");
    const int c = lane & 7;
#pragma unroll
    for (int j = 0; j < 4; ++j) { const int n = (lane >> 3) + 8 * j; const LAS float* s = scr + (8 * c) * 33 + n;
        u32x4 o; o.x = pk2(s[0 * 33], s[1 * 33]); o.y = pk2(s[2 * 33], s[3 * 33]); o.z = pk2(s[4 * 33], s[5 * 33]); o.w = pk2(s[6 * 33], s[7 * 33]);
        *(u32x4*)(WT + (size_t)(dst_row0 + n) * K + k0 + 8 * c) = o; }
    asm volatile("s_waitcnt lgkmcnt(0)" ::: "memory");
}
__device__ __forceinline__ void prologue(const Args& a, LAS unsigned char* lds, int vcu, int G, int wave_s) {
    int tid_l = my_tid(wave_s); const int tid = tid_l, lane = tid & 63, wave = __builtin_amdgcn_readfirstlane(tid >> 6);
    LAS float* scr = (LAS float*)(lds + wave * 16384);
    const int gw = vcu * 8 + wave, NGW = G * 8;
    bf16* wbase = (bf16*)(a.ws + WS_W);
    constexpr int I_AI = 16 * 256, I_AO = 32 * 32, I_SI = 16 * 192, I_SO = 32 * 32, I_J = I_AI + I_AO + I_SI + I_SO;
    for (int it = gw; it < 2 * I_J; it += NGW) {
        const int j = it / I_J; int r = it % I_J;
        if (r < I_AI) { const int kb = r / 256, nb = r % 256, n0 = nb * 32; const int dr = n0 < 4096 ? n0 : (n0 < 6144 ? n0 + 2048 : n0 - 2048);
            transpose_item(a.in[3] + (size_t)j * 1024 * 8192, a.in[2] + j * 1024, 1024, 8192, wbase + (W_ATT_IN + (size_t)j * 16 * MiB) / 2, n0, dr, kb * 64, scr, lane); continue; } r -= I_AI;
        if (r < I_AO) { const int kb = r / 32, nb = r % 32;
            transpose_item(a.in[9] + (size_t)j * 2048 * 1024, nullptr, 2048, 1024, wbase + (W_ATT_OUT + (size_t)j * 4 * MiB) / 2, nb * 32, nb * 32, kb * 64, scr, lane); continue; } r -= I_AO;
        if (r < I_SI) { const int kb = r / 192, nb = r % 192, n0 = nb * 32;
            const int dr = n0 < 2048 ? (n0 >> 7) * 256 + (n0 & 127) : (n0 < 4096 ? n0 + 2048 : ((n0 - 4096) >> 7) * 256 + 128 + (n0 & 127));
            transpose_item(a.in[11] + (size_t)j * 1024 * 6144, a.in[10] + j * 1024, 1024, 6144, wbase + (W_SGU_IN + (size_t)j * 12 * MiB) / 2, n0, dr, kb * 64, scr, lane); continue; } r -= I_SI;
        { const int kb = r / 32, nb = r % 32;
            transpose_item(a.in[15] + (size_t)j * 2048 * 1024, nullptr, 2048, 1024, wbase + (W_SGU_OUT + (size_t)j * 4 * MiB) / 2, nb * 32, nb * 32, kb * 64, scr, lane); }
    }
    const float* x = a.in[0]; bf16* xb = (bf16*)(a.ws + WS_XB); float* rstdc = (float*)(a.ws + WS_RSTD);
    for (int m0 = gw * 4; m0 < MTOK; m0 += NGW * 4) {
        f32x4 v[4][4];
#pragma unroll
        for (int q = 0; q < 4; ++q) { const f32x4* xr = (const f32x4*)(x + (size_t)(m0 + q) * DM) + lane;
#pragma unroll
            for (int j = 0; j < 4; ++j) v[q][j] = xr[64 * j]; }
#pragma unroll
        for (int q = 0; q < 4; ++q) { const int m = m0 + q; float s = 0.f;
#pragma unroll
            for (int j = 0; j < 4; ++j) s += (v[q][j][0] * v[q][j][0] + v[q][j][1] * v[q][j][1]) + (v[q][j][2] * v[q][j][2] + v[q][j][3] * v[q][j][3]);
            s = wave_sum(s);
            u32x2* o8 = (u32x2*)(xb + (size_t)m * DM) + lane;
#pragma unroll
            for (int j = 0; j < 4; ++j) { u32x2 w; w.x = pk2(v[q][j][0], v[q][j][1]); w.y = pk2(v[q][j][2], v[q][j][3]); o8[64 * j] = w; }
            if (lane == 0) rstdc[m] = 1.0f / sqrtf(s * (1.0f / 1024.0f) + 1e-6f); }
    }
    const float* wsrc = a.in[13]; bf16* wm = (bf16*)(a.ws + WS_WM);
    for (int i = vcu * 512 + tid; i < 2 * 16 * 128 * 128 / 4; i += G * 512) {
        const f32x4 w = *((const f32x4*)wsrc + i); const int e = i * 4, s = e & 127, t = (e >> 7) & 127;
        u32x2 o; o.x = pk2(s <= t ? w[0] : 0.f, s + 1 <= t ? w[1] : 0.f); o.y = pk2(s + 2 <= t ? w[2] : 0.f, s + 3 <= t ? w[3] : 0.f);
        *((u32x2*)wm + i) = o;
    }
}

namespace att {
constexpr int KST = 16384, VST = 16384, NSK = 3, NSV = 3;
constexpr int OFF_K = 0, OFF_V = NSK * KST, OFF_OSTG = 65536, OSTG_W = 32 * 272, OFF_TB = 102400, TBC = 324, OFF_END = OFF_TB + 512 + 4 * TBC * 4;
static_assert(OFF_END <= RING_BYTES && OFF_OSTG + 4 * OSTG_W <= OFF_TB && OFF_V + NSV * VST <= OFF_TB, "attention LDS map");
}
#define SGB(mask, n) __builtin_amdgcn_sched_group_barrier((mask), (n), 0)
template <int ABL> __device__ __forceinline__ void attn_unit(LAS unsigned char* lds, const bf16* Qb, bf16* Yb, const bf16* Kb, const bf16* Gb, const bf16* VTb, const float* rel_bias, const float* subln, float lam, float c1, int bl, int h, int qb, int wave_s) {
    using namespace att;
    int tid_l = my_tid(wave_s); const int tid = tid_l, lane = tid & 63, r32 = lane & 31, hi = lane >> 5;
    const int wid = __builtin_amdgcn_readfirstlane(tid >> 6), mp = wid >> 2, wq = wid & 3;
    const int rowbase = bl * SEQ, q0 = qb * 128, wfirst = q0 + 32 * wq;
    LAS float* sg = (LAS float*)(lds + OFF_TB); LAS float* tbl = sg + 128;
    if (tid < 128) sg[tid] = subln[tid];
    { const float b31 = rel_bias[31 * 16 + h];
      for (int idx = tid; idx < 4 * TBC; idx += 512) { const int c_ = idx / TBC, i_ = idx % TBC + c_, n = 223 - i_; float v = 0.f;
        if (n < 0) v = -INFINITY;
        else if (n < 113) { int bk = n; if (n >= 16) bk = 16 + (n >= 19) + (n >= 21) + (n >= 24) + (n >= 27) + (n >= 31) + (n >= 35) + (n >= 40) + (n >= 46) + (n >= 52) + (n >= 59) + (n >= 67) + (n >= 77) + (n >= 87) + (n >= 99);
            v = (rel_bias[bk * 16 + h] - b31) * LOG2E; }
        tbl[idx] = v; } }
    const int nt = 2 * (qb + 1);
    const int krow_l = 4 * wid + (lane >> 4), kchunk = (lane & 15) ^ (krow_l & 15);
    const bf16* ksrc = Kb + (size_t)(rowbase + krow_l) * BR + h * 128 + kchunk * 8;
    const int vdv_l = 8 * wid + (lane >> 3), vchunk = (lane & 7) ^ ((vdv_l >> 1) & 7);
    const bf16* vsrc = VTb + (size_t)(h * 128 + vdv_l) * HTOK + rowbase + vchunk * 8;
#define ATT_DMAK(t, sk) do { _Pragma("unroll") for (int i_ = 0; i_ < 2; ++i_) \
        __builtin_amdgcn_global_load_lds((const unsigned*)(ksrc + (size_t)(64 * (t) + 32 * i_) * BR), (LAS unsigned*)(lds + OFF_K + (sk) * KST + (wid + 8 * i_) * 1024), 16, 0, 0); } while (0)
#define ATT_DMAV(t, sv) do { _Pragma("unroll") for (int i_ = 0; i_ < 2; ++i_) \
        __builtin_amdgcn_global_load_lds((const unsigned*)(vsrc + (size_t)(64 * i_) * HTOK + 64 * (t)), (LAS unsigned*)(lds + OFF_V + (sv) * VST + (wid + 8 * i_) * 1024), 16, 0, 0); } while (0)
#define DMAK1(t, sk, i_) do { if ((t) < nt) __builtin_amdgcn_global_load_lds((const unsigned*)(ksrc + (size_t)(64 * (t) + 32 * (i_)) * BR), (LAS unsigned*)(lds + OFF_K + (sk) * KST + (wid + 8 * (i_)) * 1024), 16, 0, 0); } while (0)
#define DMAV1(t, sv, i_) do { if ((t) < nt) __builtin_amdgcn_global_load_lds((const unsigned*)(vsrc + (size_t)(64 * (i_)) * HTOK + 64 * (t)), (LAS unsigned*)(lds + OFF_V + (sv) * VST + (wid + 8 * (i_)) * 1024), 16, 0, 0); } while (0)
    ATT_DMAK(0, 0); ATT_DMAK(1, 1); ATT_DMAV(0, 0); if (nt > 2) ATT_DMAK(2, 2); ATT_DMAV(1, 1);
    bf16x8 qf[4];
    { const bf16* qp = Qb + (size_t)(rowbase + wfirst + r32) * BR + h * 128 + mp * 64 + hi * 8;
#pragma unroll
      for (int c = 0; c < 4; ++c) qf[c] = *(const bf16x8*)(qp + 16 * c); }
    const int pirow = (r32 & ~12) | ((r32 & 4) << 1) | ((r32 & 8) >> 1);
    int kaddr[4], vaddr[4];
#pragma unroll
    for (int c = 0; c < 4; ++c) { kaddr[c] = OFF_K + pirow * 256 + (((mp * 8 + 2 * c + hi) ^ (pirow & 15)) << 4); vaddr[c] = OFF_V + r32 * 128 + (((2 * c + hi) ^ ((r32 >> 1) & 7)) << 4); }
    float mu = 0.f, l = 0.f; f32x16 o[4], negm;
#pragma unroll
    for (int r = 0; r < 16; ++r) { o[0][r] = 0.f; o[1][r] = 0.f; o[2][r] = 0.f; o[3][r] = 0.f; }
    const int nact = min(nt, (wfirst + 31) / 64 + 1);
#define ATT_NEAR(x0, x1, tt) do { if (64 * (tt) + 63 + 113 > wfirst) { const int i0_ = 223 - (wfirst + r32 - 64 * (tt) - 8 * hi), c_ = i0_ & 3; const LAS float* tp_ = tbl + c_ * TBC + (i0_ - c_); f32x4 b_; \
        b_ = *(const LAS f32x4*)(tp_);      x0[0] += b_[0]; x0[1] += b_[1]; x0[2] += b_[2]; x0[3] += b_[3];     b_ = *(const LAS f32x4*)(tp_ + 4);  x0[4] += b_[0]; x0[5] += b_[1]; x0[6] += b_[2]; x0[7] += b_[3]; \
        b_ = *(const LAS f32x4*)(tp_ + 16); x0[8] += b_[0]; x0[9] += b_[1]; x0[10] += b_[2]; x0[11] += b_[3];  b_ = *(const LAS f32x4*)(tp_ + 20); x0[12] += b_[0]; x0[13] += b_[1]; x0[14] += b_[2]; x0[15] += b_[3]; \
        b_ = *(const LAS f32x4*)(tp_ + 32); x1[0] += b_[0]; x1[1] += b_[1]; x1[2] += b_[2]; x1[3] += b_[3];     b_ = *(const LAS f32x4*)(tp_ + 36); x1[4] += b_[0]; x1[5] += b_[1]; x1[6] += b_[2]; x1[7] += b_[3]; \
        b_ = *(const LAS f32x4*)(tp_ + 48); x1[8] += b_[0]; x1[9] += b_[1]; x1[10] += b_[2]; x1[11] += b_[3];  b_ = *(const LAS f32x4*)(tp_ + 52); x1[12] += b_[0]; x1[13] += b_[1]; x1[14] += b_[2]; x1[15] += b_[3]; } } while (0)
#define ATT_ROWMAX(x0, x1, mx) do { mx = fmaxf(fmaxf(x0[0], x1[0]), fmaxf(x0[1], x1[1])); \
        _Pragma("unroll") for (int r = 2; r < 16; r += 2) mx = fmaxf(fmaxf(mx, x0[r]), fmaxf(x1[r], fmaxf(x0[r + 1], x1[r + 1]))); mx = swap_max(mx); } while (0)
    bf16x8 pb[4], pc[4];
#pragma unroll
    for (int c = 0; c < 4; ++c) pc[c] = (bf16x8){0, 0, 0, 0, 0, 0, 0, 0};
    asm volatile("s_waitcnt vmcnt(6)" ::: "memory"); __builtin_amdgcn_s_barrier(); asm volatile("" ::: "memory");
    {
        f32x16 s0, s1;
#pragma unroll
        for (int r = 0; r < 16; ++r) { s0[r] = 0.f; s1[r] = 0.f; }
        bf16x8 kf[8];
#pragma unroll
        for (int c = 0; c < 4; ++c) { kf[2 * c] = *(const LAS bf16x8*)(lds + kaddr[c]); kf[2 * c + 1] = *(const LAS bf16x8*)(lds + kaddr[c] + 8192); }
#pragma unroll
        for (int c = 0; c < 4; ++c) { s0 = MFMA32(kf[2 * c], qf[c], s0); s1 = MFMA32(kf[2 * c + 1], qf[c], s1); }
        ATT_NEAR(s0, s1, 0);
        float mx; ATT_ROWMAX(s0, s1, mx);
        mu = mx; float sum = 0.f;
#pragma unroll
        for (int r = 0; r < 16; ++r) { negm[r] = -mx; s0[r] = __builtin_amdgcn_exp2f(s0[r] - mx); s1[r] = __builtin_amdgcn_exp2f(s1[r] - mx); sum += s0[r] + s1[r]; }
        l = sum;
        u32x4 w;
        w.x = pk2(s0[0], s0[1]); w.y = pk2(s0[2], s0[3]); w.z = pk2(s0[4], s0[5]); w.w = pk2(s0[6], s0[7]); pb[0] = __builtin_bit_cast(bf16x8, w);
        w.x = pk2(s0[8], s0[9]); w.y = pk2(s0[10], s0[11]); w.z = pk2(s0[12], s0[13]); w.w = pk2(s0[14], s0[15]); pb[1] = __builtin_bit_cast(bf16x8, w);
        w.x = pk2(s1[0], s1[1]); w.y = pk2(s1[2], s1[3]); w.z = pk2(s1[4], s1[5]); w.w = pk2(s1[6], s1[7]); pb[2] = __builtin_bit_cast(bf16x8, w);
        w.x = pk2(s1[8], s1[9]); w.y = pk2(s1[10], s1[11]); w.z = pk2(s1[12], s1[13]); w.w = pk2(s1[14], s1[15]); pb[3] = __builtin_bit_cast(bf16x8, w);
    }
    int sk1 = 1, sk3 = 0, sv0 = 0, sv2 = 2;
#define SBAR() __builtin_amdgcn_sched_barrier(0)
#define VLD(i) (*(const LAS bf16x8*)(vs_ + vaddr[(i) >> 2] + ((i) & 3) * 4096))
#define PVG(i, EXPS) do { o[(i) & 3] = MFMA32(vf[(i) % 4], PBI_[(i) >> 2], o[(i) & 3]); if ((i) + 4 < 16) vf[(i) % 4] = VLD((i) + 4); EXPS; SBAR(); } while (0)
#define EXG(nn, r, W, C) do { const float a_ = __builtin_amdgcn_exp2f(nn[r]), b_ = __builtin_amdgcn_exp2f(nn[r + 1]); sum = fadd_s(sum, a_); sumb = fadd_s(sumb, b_); W.C = pk2(a_, b_); asm volatile("" : "+v"(sum), "+v"(sumb), "+v"(W.C)); } while (0)
#define KLD(i) (*(const LAS bf16x8*)(ks + kaddr[(i) >> 1] + ((i) & 1) * 8192))
#define ATT_ITER(T_, PBIN, PBO_) do { bf16x8 (&PBI_)[4] = PBIN; \
        if (T_ + 2 < nt) asm volatile("s_waitcnt vmcnt(4)" ::: "memory"); else if (T_ + 1 < nt) asm volatile("s_waitcnt vmcnt(2)" ::: "memory"); else asm volatile("s_waitcnt vmcnt(0)" ::: "memory"); \
        __builtin_amdgcn_s_barrier(); asm volatile("" ::: "memory"); \
        if (T_ >= nact) { if (T_ + 3 < nt) ATT_DMAK(T_ + 3, sk3); if (T_ + 2 < nt) ATT_DMAV(T_ + 2, sv2); } \
        if (T_ < nact) { \
            const LAS unsigned char* vs_ = lds + sv0 * VST; \
            if (T_ + 1 < nact) { \
                const LAS unsigned char* ks = lds + sk1 * KST; \
                bf16x8 kf[4]; f32x16 n0, n1; float sum = 0.f, sumb = 0.f; u32x4 w0, w1, w2, w3; float alpha = 1.f; \
                kf[0] = KLD(0); kf[1] = KLD(1); kf[2] = KLD(2); SBAR(); \
                n0 = MFMA32(kf[0], qf[0], negm); kf[3] = KLD(3); SBAR(); \
                n1 = MFMA32(kf[1], qf[0], negm); kf[0] = KLD(4); SBAR(); \
                n0 = MFMA32(kf[2], qf[1], n0); kf[1] = KLD(5); SBAR(); \
                n1 = MFMA32(kf[3], qf[1], n1); kf[2] = KLD(6); SBAR(); \
                n0 = MFMA32(kf[0], qf[2], n0); kf[3] = KLD(7); SBAR(); \
                n1 = MFMA32(kf[1], qf[2], n1); SBAR(); \
                n0 = MFMA32(kf[2], qf[3], n0); SBAR(); \
                n1 = MFMA32(kf[3], qf[3], n1); \
                bf16x8 vf[4]; vf[0] = VLD(0); vf[1] = VLD(1); vf[2] = VLD(2); vf[3] = VLD(3); SBAR(); \
                ATT_NEAR(n0, n1, T_ + 1); \
                SBAR(); \
                PVG(0, EXG(n0, 0, w0, x)); PVG(1, EXG(n0, 2, w0, y); DMAK1(T_ + 3, sk3, 0)); PVG(2, EXG(n0, 4, w0, z)); PVG(3, EXG(n0, 6, w0, w)); \
                PVG(4, EXG(n0, 8, w1, x)); PVG(5, EXG(n0, 10, w1, y); DMAK1(T_ + 3, sk3, 1)); PVG(6, EXG(n0, 12, w1, z)); PVG(7, EXG(n0, 14, w1, w)); \
                PVG(8, EXG(n1, 0, w2, x)); PVG(9, EXG(n1, 2, w2, y); DMAV1(T_ + 2, sv2, 0)); PVG(10, EXG(n1, 4, w2, z)); PVG(11, EXG(n1, 6, w2, w)); \
                PVG(12, EXG(n1, 8, w3, x)); PVG(13, EXG(n1, 10, w3, y); DMAV1(T_ + 2, sv2, 1)); PVG(14, EXG(n1, 12, w3, z)); PVG(15, EXG(n1, 14, w3, w)); \
                float tot_ = sum + sumb; \
                if (__any(!(tot_ <= 4096.0f))) { \
                    float mx; ATT_ROWMAX(n0, n1, mx); \
                    const float dl = mx > 8.0f ? mx : 0.f; mu += dl; alpha = __builtin_amdgcn_exp2f(-dl); l *= alpha; \
                    float s2_ = 0.f; \
_Pragma("unroll") \
                    for (int r = 0; r < 16; ++r) { n0[r] = __builtin_amdgcn_exp2f(n0[r] - dl); n1[r] = __builtin_amdgcn_exp2f(n1[r] - dl); s2_ += n0[r] + n1[r]; negm[r] = -mu; \
                        o[0][r] *= alpha; o[1][r] *= alpha; o[2][r] *= alpha; o[3][r] *= alpha; } \
                    tot_ = s2_; \
                    w0.x = pk2(n0[0], n0[1]); w0.y = pk2(n0[2], n0[3]); w0.z = pk2(n0[4], n0[5]); w0.w = pk2(n0[6], n0[7]); \
                    w1.x = pk2(n0[8], n0[9]); w1.y = pk2(n0[10], n0[11]); w1.z = pk2(n0[12], n0[13]); w1.w = pk2(n0[14], n0[15]); \
                    w2.x = pk2(n1[0], n1[1]); w2.y = pk2(n1[2], n1[3]); w2.z = pk2(n1[4], n1[5]); w2.w = pk2(n1[6], n1[7]); \
                    w3.x = pk2(n1[8], n1[9]); w3.y = pk2(n1[10], n1[11]); w3.z = pk2(n1[12], n1[13]); w3.w = pk2(n1[14], n1[15]); \
                } \
                l += tot_; \
                PBO_[0] = __builtin_bit_cast(bf16x8, w0); PBO_[1] = __builtin_bit_cast(bf16x8, w1); PBO_[2] = __builtin_bit_cast(bf16x8, w2); PBO_[3] = __builtin_bit_cast(bf16x8, w3); \
            } else { \
                bf16x8 vf[4]; vf[0] = VLD(0); vf[1] = VLD(1); vf[2] = VLD(2); vf[3] = VLD(3); SBAR(); \
                PVG(0, (void)0); PVG(1, DMAK1(T_ + 3, sk3, 0)); PVG(2, (void)0); PVG(3, (void)0); PVG(4, (void)0); PVG(5, DMAK1(T_ + 3, sk3, 1)); PVG(6, (void)0); PVG(7, (void)0); \
                PVG(8, (void)0); PVG(9, DMAV1(T_ + 2, sv2, 0)); PVG(10, (void)0); PVG(11, (void)0); PVG(12, (void)0); PVG(13, DMAV1(T_ + 2, sv2, 1)); PVG(14, (void)0); PVG(15, (void)0); \
            } \
        } \
        sk1 = (sk1 == 2) ? 0 : sk1 + 1; sk3 = (sk3 == 2) ? 0 : sk3 + 1; sv0 = (sv0 == 2) ? 0 : sv0 + 1; sv2 = (sv2 == 2) ? 0 : sv2 + 1; \
    } while (0)
#pragma unroll 1
    for (int t = 0; t < (ABL == 5 ? 0 : nt); t += 2) { ATT_ITER(t, pb, pc); ATT_ITER(t + 1, pc, pb); }
#undef ATT_ITER
#undef KLD
#undef SBAR
#undef VLD
#undef PVG
#undef EXG
#undef ATT_DMAK
#undef DMAK1
#undef DMAV1
#undef ATT_DMAV
#undef ATT_NEAR
#undef ATT_ROWMAX
    asm volatile("s_waitcnt vmcnt(0) lgkmcnt(0)" ::: "memory"); __builtin_amdgcn_s_barrier(); asm volatile("" ::: "memory");
    const float inv = 1.0f / swap_sum(l);
    u32x4 gpre[8];
    if (mp == 0) {
#pragma unroll
        for (int i = 0; i < 8; ++i) { const int p = lane + 64 * i, row = p >> 4, ch = p & 15; gpre[i] = *(const u32x4*)(Gb + (size_t)(rowbase + wfirst + row) * BR + h * 128 + ch * 8); }
    }
    LAS float* oc = (LAS float*)lds + wq * 4096 + lane;
    if (mp == 1) {
#pragma unroll
        for (int b = 0; b < 4; ++b)
#pragma unroll
            for (int r = 0; r < 16; ++r) oc[(b * 16 + r) * 64] = o[b][r] * inv;
    }
    __syncthreads();
    if (mp == 0) {
        float ss = 0.f;
#pragma unroll
        for (int b = 0; b < 4; ++b)
#pragma unroll
            for (int r = 0; r < 16; ++r) { const float d = o[b][r] * inv - lam * oc[(b * 16 + r) * 64]; o[b][r] = d; ss += d * d; }
        ss = swap_sum(ss);
        const float rs = c1 / sqrtf(ss * (1.0f / 128.0f) + 1e-6f);
        LAS unsigned char* stg = lds + OFF_OSTG + wq * OSTG_W;
#pragma unroll
        for (int b = 0; b < 4; ++b)
#pragma unroll
            for (int g4 = 0; g4 < 4; ++g4) { const int dv0 = 32 * b + 8 * g4 + 4 * hi; const f32x4 gg = *(const LAS f32x4*)(sg + dv0);
                u32x2 w; w.x = pk2(o[b][4 * g4] * rs * gg[0], o[b][4 * g4 + 1] * rs * gg[1]); w.y = pk2(o[b][4 * g4 + 2] * rs * gg[2], o[b][4 * g4 + 3] * rs * gg[3]);
                *(LAS u32x2*)(stg + r32 * 272 + dv0 * 2) = w; }
        asm volatile("s_waitcnt lgkmcnt(0)" ::: "memory");
#pragma unroll
        for (int i = 0; i < 8; ++i) { const int p = lane + 64 * i, row = p >> 4, ch = p & 15;
            const u32x4 ov = *(const LAS u32x4*)(stg + row * 272 + ch * 16);
            const size_t goff = (size_t)(rowbase + wfirst + row) * BR + h * 128 + ch * 8;
            const u32x4 gv = gpre[i]; u32x4 y;
#pragma unroll
            for (int e = 0; e < 4; ++e) { const float o0 = __uint_as_float(ov[e] << 16), o1 = __uint_as_float(ov[e] & 0xffff0000u), g0 = __uint_as_float(gv[e] << 16), g1 = __uint_as_float(gv[e] & 0xffff0000u);
                y[e] = pk2(o0 * silu_f(g0), o1 * silu_f(g1)); }
            *(u32x4*)(Yb + goff) = y; }
    }
    __syncthreads();
}

struct SguV { f32x4 vq[8]; u32x4 va[2], vb2[2]; bf16x8 af[8]; };
__device__ __forceinline__ void sgu_issue_v(SguV& S, const bf16* Vb, const float* vss, const bf16* Wm, int row0, int g, int tid) {
    const int lane = tid & 63, r32 = lane & 31, hi = lane >> 5; const int wid = __builtin_amdgcn_readfirstlane(tid >> 6), tbk = wid & 3;
    { const f32x4* p = (const f32x4*)(vss + (size_t)(row0 + (tid & 127)) * 32);
#pragma unroll
      for (int i = 0; i < 8; ++i) S.vq[i] = p[i]; }
#pragma unroll
    for (int i = 0; i < 2; ++i) { const int p = tid + 512 * i, sp = p & 63, chk = p >> 6, s = 2 * sp;
        S.va[i] = *(const u32x4*)(Vb + (size_t)(row0 + s) * BR + g * 128 + chk * 8); S.vb2[i] = *(const u32x4*)(Vb + (size_t)(row0 + s + 1) * BR + g * 128 + chk * 8); }
    const bf16* wrow = Wm + (size_t)(g * 128 + 32 * tbk + r32) * 128 + 8 * hi;
#pragma unroll
    for (int c = 0; c < 8; ++c) S.af[c] = *(const bf16x8*)(wrow + 16 * c);
}
__device__ __forceinline__ void sgu_phase(LAS unsigned char* lds, const bf16* Ub, bf16* Ob, const bf16* Vb, const bf16* Gb, const float* vss, const bf16* Wm, const float* vgain, const float* bs, int vcu, int G, int wave_s) {
    int tid_l = my_tid(wave_s); const int tid = tid_l, lane = tid & 63, r32 = lane & 31, hi = lane >> 5;
    const int wid = __builtin_amdgcn_readfirstlane(tid >> 6), tbk = wid & 3, cw = wid >> 2;
    LAS float* rs = (LAS float*)lds; LAS unsigned char* vT = lds + 512;
    LAS float* yl = (LAS float*)(lds + 36864);
    SguV N;
    if (vcu < 2048) sgu_issue_v(N, Vb, vss, Wm, (vcu >> 4) * 128, vcu & 15, tid);
#pragma unroll 1
    for (int u = vcu; u < 2048; u += G) {
        const int row0 = (u >> 4) * 128, g = u & 15;
        SguV C = N;
        u32x4 uv[4]; float gn[2], bsv[16];
#pragma unroll
        for (int i = 0; i < 4; ++i) { const int p = tid + 512 * i, row = p >> 4, ck = p & 15; const size_t off = (size_t)(row0 + row) * BR + g * 128 + ck * 8;
            uv[i] = *(const u32x4*)(Ub + off); }
#pragma unroll
        for (int b = 0; b < 2; ++b) gn[b] = vgain[g * 128 + 64 * cw + 32 * b + r32];
#pragma unroll
        for (int r = 0; r < 16; ++r) bsv[r] = bs[g * 128 + 32 * tbk + crow(r, hi)];
        if (tid < 128) { float s = 0.f;
#pragma unroll
            for (int i = 0; i < 8; ++i) s += (C.vq[i][0] + C.vq[i][1]) + (C.vq[i][2] + C.vq[i][3]);
            rs[tid] = 1.0f / sqrtf(s * (1.0f / 2048.0f) + 1e-6f); }
        __syncthreads();
#pragma unroll
        for (int i = 0; i < 2; ++i) { const int p = tid + 512 * i, sp = p & 63, chk = p >> 6, s = 2 * sp;
            const float ra = rs[s], rb = rs[s + 1];
#pragma unroll
            for (int e = 0; e < 4; ++e) { const float a0 = __uint_as_float(C.va[i][e] << 16) * ra, a1 = __uint_as_float(C.va[i][e] & 0xffff0000u) * ra, b0 = __uint_as_float(C.vb2[i][e] << 16) * rb, b1 = __uint_as_float(C.vb2[i][e] & 0xffff0000u) * rb;
                *(LAS unsigned*)(vT + (chk * 8 + 2 * e) * 272 + s * 2) = pk2(a0, b0); *(LAS unsigned*)(vT + (chk * 8 + 2 * e + 1) * 272 + s * 2) = pk2(a1, b1); } }
        __syncthreads();
        f32x16 acc[2];
#pragma unroll
        for (int b = 0; b < 2; ++b)
#pragma unroll
            for (int r = 0; r < 16; ++r) acc[b][r] = 0.f;
        const LAS unsigned char* vbp = vT + (64 * cw + r32) * 272 + hi * 16;
#pragma unroll
        for (int c = 0; c < 8; ++c) if (c <= 2 * tbk + 1) {
#pragma unroll
            for (int b = 0; b < 2; ++b) { const bf16x8 bfr = *(const LAS bf16x8*)(vbp + b * 32 * 272 + c * 32); acc[b] = MFMA32(C.af[c], bfr, acc[b]); } }
#pragma unroll
        for (int b = 0; b < 2; ++b) { const int chl = 64 * cw + 32 * b + r32;
#pragma unroll
            for (int r = 0; r < 16; ++r) { const int t = 32 * tbk + crow(r, hi); yl[t * 132 + chl] = acc[b][r] * gn[b] + bsv[r]; } }
        if (u + G < 2048) sgu_issue_v(N, Vb, vss, Wm, ((u + G) >> 4) * 128, (u + G) & 15, tid);
        __syncthreads();
#pragma unroll
        for (int i = 0; i < 4; ++i) { const int p = tid + 512 * i, row = p >> 4, ck = p & 15; const size_t off = (size_t)(row0 + row) * BR + g * 128 + ck * 8;
            const f32x4 y0 = *(const LAS f32x4*)(yl + row * 132 + ck * 8), y1 = *(const LAS f32x4*)(yl + row * 132 + ck * 8 + 4); u32x4 w;
#pragma unroll
            for (int e = 0; e < 4; ++e) { const float u0 = __uint_as_float(uv[i][e] << 16), u1 = __uint_as_float(uv[i][e] & 0xffff0000u);
                const float ya = e < 2 ? y0[2 * e] : y1[2 * e - 4], yb = e < 2 ? y0[2 * e + 1] : y1[2 * e - 3];
                w[e] = pk2(ya * u0, yb * u1); }
            *(u32x4*)(Ob + off) = w; }
        asm volatile("s_waitcnt lgkmcnt(0)" ::: "memory"); __builtin_amdgcn_s_barrier(); asm volatile("" ::: "memory");
    }
}
#define XB_TMO      128
#define XB_XCNT(j)  (256  + 64 * (j))
#define XB_XSUB(j)  (1280 + 64 * (j))
#define XB_XGEN(j)  (2304 + 64 * (j))
#define XB_TOP      3328
#define XB_TOPGEN   3392
#define XCD_BAR_WORDS 3456
#define XB_SPIN_CAP (1u << 18)

__device__ __forceinline__ unsigned xb_ld(unsigned* p)              { return __hip_atomic_load(p, __ATOMIC_RELAXED, __HIP_MEMORY_SCOPE_AGENT); }
__device__ __forceinline__ unsigned xb_add(unsigned* p, unsigned v) { return __hip_atomic_fetch_add(p, v, __ATOMIC_RELAXED, __HIP_MEMORY_SCOPE_AGENT); }
__device__ __forceinline__ unsigned xb_xcc_id() { return (unsigned)__builtin_amdgcn_s_getreg((3 << 11) | 20) & 0xFu; }
#define XB_SPIN(cond, bar) do { unsigned _sp = 0; while (cond) { __builtin_amdgcn_s_sleep(1); \
    if ((++_sp & 255u) == 0u) { if (xb_ld(&(bar)[XB_TMO])) break; if (_sp > XB_SPIN_CAP) { atomicAdd(&(bar)[XB_TMO], 1u); break; } } } } while (0)

struct XcdBarrier {
    unsigned* bar; unsigned x;
    volatile LAS unsigned* st;
};

__device__ __forceinline__ XcdBarrier xcd_barrier_post(unsigned* bar, volatile LAS unsigned* st, int tid_) {
    XcdBarrier b; b.bar = bar; b.x = xb_xcc_id(); b.st = st;
    if (tid_ == 0) (void)xb_add(&bar[XB_XCNT(b.x)], 1u);
    return b;
}
__device__ __forceinline__ void xcd_barrier_complete(unsigned* bar, unsigned x, unsigned& nloc, unsigned& nx) {
    const unsigned G = gridDim.x * gridDim.y * gridDim.z;
    unsigned sum, cnt, mine, sp = 0u;
    for (;;) {
        sum = 0u; cnt = 0u; mine = 0u;
#pragma unroll
        for (unsigned j = 0; j < 16; ++j) { const unsigned c = xb_ld(&bar[XB_XCNT(j)]); sum += c; cnt += (c > 0u) ? 1u : 0u; mine = (j == x) ? c : mine; }
        if (sum == G) break;
        __builtin_amdgcn_s_sleep(1);
        if ((++sp & 255u) == 0u) { if (xb_ld(&bar[XB_TMO])) break; if (sp > XB_SPIN_CAP) { atomicAdd(&bar[XB_TMO], 1u); break; } }
    }
    nloc = mine > 0u ? mine : 1u; nx = cnt > 0u ? cnt : 1u;
}

__device__ __forceinline__ void xcd_barrier(const XcdBarrier& b, int tid_) {
    asm volatile("s_waitcnt vmcnt(0)" ::: "memory");
    __syncthreads();
    if (tid_ == 0) {
        unsigned* bar = b.bar;
        __builtin_amdgcn_s_waitcnt(0);
        unsigned nloc = b.st[0], nx = b.st[1];
        if (nloc == 0u) { xcd_barrier_complete(bar, b.x, nloc, nx); b.st[0] = nloc; b.st[1] = nx; }
        const unsigned old = xb_add(&bar[XB_XSUB(b.x)], 1u);
        const unsigned gen = old / nloc;
        if (old + 1u == (gen + 1u) * nloc) {
            __builtin_amdgcn_fence(__ATOMIC_RELEASE, "agent");
            asm volatile("s_waitcnt vmcnt(0)" ::: "memory");
            const unsigned og = xb_add(&bar[XB_TOP], 1u);
            const unsigned tg = og / nx;
            if (og + 1u == (tg + 1u) * nx) xb_add(&bar[XB_TOPGEN], 1u);
            else XB_SPIN(xb_ld(&bar[XB_TOPGEN]) == tg, bar);
            __builtin_amdgcn_fence(__ATOMIC_ACQUIRE, "agent");
            xb_add(&bar[XB_XGEN(b.x)], 1u);
            asm volatile("s_waitcnt vmcnt(0)" ::: "memory");
        } else {
            XB_SPIN(xb_ld(&bar[XB_XGEN(b.x)]) == gen, bar);
            __builtin_amdgcn_fence(__ATOMIC_ACQUIRE, "agent");
            asm volatile("s_waitcnt vmcnt(0)" ::: "memory");
        }
    }
    __syncthreads();
}
__global__ void __launch_bounds__(512, 2) mega_fwd(Args a) {
    extern __shared__ __attribute__((aligned(16))) unsigned char lds_raw[];
    LAS unsigned char* lds = (LAS unsigned char*)lds_raw;
    cg::grid_group grid = cg::this_grid();
    volatile LAS unsigned* MISC = (volatile LAS unsigned*)(lds + RING_BYTES + 320);
    const int wave_s = __builtin_amdgcn_readfirstlane(threadIdx.x >> 6);
    { const int t0 = my_tid(wave_s); if (t0 < 32) MISC[t0] = 0u; }
    __syncthreads();
    XcdBarrier bar = xcd_barrier_post((unsigned*)a.ws, MISC + 8, my_tid(wave_s));
    const int G = gridDim.x, bx = blockIdx.x, vcu = (G % 8 == 0) ? (bx % 8) * (G / 8) + bx / 8 : bx;
    unsigned char* ws = a.ws;
    bf16* xb = (bf16*)(ws + WS_XB); float* rowss = (float*)(ws + WS_ROWSS); float* vss = (float*)(ws + WS_VSS);
    bf16* act = (bf16*)(ws + WS_ACT); bf16* wbase = (bf16*)(ws + WS_W);
    bf16* ybuf = (bf16*)(ws + WS_END);
    for (int ph = a.ph_lo; ph < a.ph_hi; ++ph) {
        int tid_l = my_tid(wave_s); const int tid = tid_l, lane = tid & 63, wave = __builtin_amdgcn_readfirstlane(tid >> 6);
        if (ph == 0) prologue(a, lds, vcu, G, wave_s);
        else if (ph == NPHASE - 1) {
            const float* gf = a.in[16];
            for (int m = vcu * 8 + wave; m < MTOK; m += G * 8) { const u32x2* xr = (const u32x2*)(xb + (size_t)m * DM) + lane; f32x4 v[4]; float s = 0.f;
#pragma unroll
                for (int j = 0; j < 4; ++j) { const u32x2 w = xr[64 * j]; v[j][0] = __uint_as_float(w.x << 16); v[j][1] = __uint_as_float(w.x & 0xffff0000u); v[j][2] = __uint_as_float(w.y << 16); v[j][3] = __uint_as_float(w.y & 0xffff0000u);
                    s += (v[j][0] * v[j][0] + v[j][1] * v[j][1]) + (v[j][2] * v[j][2] + v[j][3] * v[j][3]); }
                const float rstd = 1.0f / sqrtf(wave_sum(s) * (1.0f / DM) + 1e-6f);
                f32x4* orow = (f32x4*)(a.out + (size_t)m * DM) + lane;
#pragma unroll
                for (int j = 0; j < 4; ++j) { const f32x4 gg = *((const f32x4*)gf + lane + 64 * j); orow[64 * j] = v[j] * rstd * gg; } }
        } else {
            const int q8p = (ph - 2) >> 1; const bool odd = (ph & 1) != 0;
            const int nsub = (ph > 1 && odd && q8p < 7) ? 2 : 1;
            for (int sub = 0; sub < nsub; ++sub) {
            const int st = (ph == 1) ? 0 : (!odd ? 1 : (sub == 0 ? 2 : 0));
            const int q8 = (ph == 1) ? 0 : q8p + (sub == 1 ? 1 : 0);
            const int L = q8 >> 1, hb = q8 & 1, j = L >> 1; const bool is_attn = (L & 1) == 0;
            const bf16* xbh = xb + (size_t)hb * HTOK * DM; const float* rssh = (const float*)(ws + WS_RSTD) + (size_t)hb * HTOK;
            if (st == 0) {
                const bf16* wt = is_attn ? wbase + (W_ATT_IN + (size_t)j * 16 * MiB) / 2 : wbase + (W_SGU_IN + (size_t)j * 12 * MiB) / 2;
                { pg8::Gemm g{xbh, wt, HTOK, 6144, DM}; pg8::StaticOrder S; S.init(HTOK, 6144, G, bx);
                  pg8::EpiIn E{act, BR, BR, ACT_STRIDE, QSCALE, is_attn ? 8 : 0, rssh, vss, is_attn ? 0 : 16, is_attn ? 0 : 24, is_attn ? 0 : 16};
                  pg8::gemm_phase<pg8::EpiIn, pg8::StaticOrder, true, true>(lds, g, S, E, wave_s); }
                if (is_attn) { pg8::Gemm g{wt + (size_t)6144 * DM, xbh, BR, HTOK, DM}; pg8::StaticOrder S; S.init(BR, HTOK, G, bx);
                  pg8::EpiVT E{act + 3 * ACT_STRIDE, HTOK, rssh};
                  pg8::gemm_phase<pg8::EpiVT, pg8::StaticOrder, true, true>(lds, g, S, E, wave_s); }
            } else if (st == 1) {
                if ((hb == 1 || L > 0) && tid < 64) {
                    for (int r_ = bx * 64 + tid; r_ < HTOK; r_ += G * 64) { const int row = (1 - hb) * HTOK + r_; ((float*)(ws + WS_RSTD))[row] = pg8::rstd16(rowss + (size_t)row * 16); } }
                if (is_attn) {
                    const float lam_init = (L == 0) ? 0.2f : 0.47071302f;
                    const float d1 = wave_sum(a.in[4][j * 64 + lane] * a.in[5][j * 64 + lane]), d2 = wave_sum(a.in[6][j * 64 + lane] * a.in[7][j * 64 + lane]);
                    const float lam = expf(d1) - expf(d2) + lam_init;
                    if (PROBE_DUP == 1) { bf16* yb2 = ybuf;
                      for (int p = vcu; p < 1024; p += G) { const int bh = p >> 4, s = p & 15;
                        attn_unit<PROBE_ABL>(lds, act, yb2, act + ACT_STRIDE, act + 2 * ACT_STRIDE, act + 3 * ACT_STRIDE, a.in[1], a.in[8] + j * 128, lam, 1.0f - lam_init, bh >> 4, bh & 15, 31 - s, wave_s);
                        attn_unit<PROBE_ABL>(lds, act, yb2, act + ACT_STRIDE, act + 2 * ACT_STRIDE, act + 3 * ACT_STRIDE, a.in[1], a.in[8] + j * 128, lam, 1.0f - lam_init, bh >> 4, bh & 15, s, wave_s); } }
                    for (int p = vcu; p < 1024; p += G) { const int bh = p >> 4, s = p & 15;
                        attn_unit<0>(lds, act, ybuf, act + ACT_STRIDE, act + 2 * ACT_STRIDE, act + 3 * ACT_STRIDE, a.in[1], a.in[8] + j * 128, lam, 1.0f - lam_init, bh >> 4, bh & 15, 31 - s, wave_s);
                        attn_unit<0>(lds, act, ybuf, act + ACT_STRIDE, act + 2 * ACT_STRIDE, act + 3 * ACT_STRIDE, a.in[1], a.in[8] + j * 128, lam, 1.0f - lam_init, bh >> 4, bh & 15, s, wave_s); }
                } else {
                    const bf16* wm = (const bf16*)(ws + WS_WM) + (size_t)j * 16 * 128 * 128;
                    sgu_phase(lds, act, ybuf, act + ACT_STRIDE, act + 2 * ACT_STRIDE, vss, wm, a.in[12] + j * BR, a.in[14] + j * 16 * 128, vcu, G, wave_s);
                }
            } else {
                const bf16* wt = is_attn ? wbase + (W_ATT_OUT + (size_t)j * 4 * MiB) / 2 : wbase + (W_SGU_OUT + (size_t)j * 4 * MiB) / 2;
                pg8::Gemm g{ybuf, wt, HTOK, DM, BR}; pg8::StaticOrder S; S.init(HTOK, DM, G, bx);
                pg8::EpiOut E{L == 0 ? a.in[0] : nullptr, xb, rowss, hb * HTOK};
                pg8::gemm_phase<pg8::EpiOut, pg8::StaticOrder, true, true>(lds, g, S, E, wave_s);
            }
            }
        }
        if (ph + 1 < a.ph_hi) { if (ph == 0 && a.pad0 != 0) grid.sync(); else xcd_barrier(bar, my_tid(wave_s)); }
    }
}

extern "C" void kernel_launch(void* const* d_in, const int* in_sizes, int n_in, void* d_out, int out_size, void* d_ws, size_t ws_size, hipStream_t stream) {
    static int grid = 0;
    if (grid == 0) {
        if (n_in != 17 || out_size != MTOK * DM || ws_size < WS_END + 64 * MiB) { fprintf(stderr, "kernel_launch: unexpected shapes: n_in %d out %d ws %zu\n", n_in, out_size, ws_size); grid = -1; return; }
        int dev = 0, cus = 0, per_cu = 0;
        hipGetDevice(&dev); hipDeviceGetAttribute(&cus, hipDeviceAttributeMultiprocessorCount, dev);
        if (hipFuncSetAttribute((const void*)mega_fwd, hipFuncAttributeMaxDynamicSharedMemorySize, LDS_BYTES) != hipSuccess) { fprintf(stderr, "kernel_launch: hipFuncSetAttribute failed\n"); grid = -1; return; }
        if (hipOccupancyMaxActiveBlocksPerMultiprocessor(&per_cu, (const void*)mega_fwd, 512, LDS_BYTES) != hipSuccess || per_cu < 1) { fprintf(stderr, "kernel_launch: occupancy query gives %d\n", per_cu); per_cu = 1; }
        (void)hipGetLastError();
        grid = cus * per_cu; if (grid > 256) grid = 256;
        fprintf(stderr, "kernel_launch: grid %d (cus %d per_cu %d) ws %zu\n", grid, cus, per_cu, ws_size);
    }
    if (grid < 0) return;
    if (hipMemsetAsync(d_ws, 0, 65536, stream) != hipSuccess) { fprintf(stderr, "kernel_launch: memset failed\n"); return; }
    Args a{};
    for (int i = 0; i < 17; ++i) a.in[i] = (const float*)d_in[i];
    a.out = (float*)d_out; a.ws = (unsigned char*)d_ws;
#if ONE_LAUNCH
    a.ph_lo = 0; a.ph_hi = NPHASE;
    void* kargs[] = {&a};
    hipError_t e = hipLaunchCooperativeKernel((const void*)mega_fwd, dim3(grid), dim3(512), kargs, LDS_BYTES, stream);
    if (e != hipSuccess) fprintf(stderr, "kernel_launch: cooperative launch failed: %s (grid %d)\n", hipGetErrorString(e), grid);
#else
    for (int ph = 0; ph < NPHASE; ++ph) { a.ph_lo = ph; a.ph_hi = ph + 1; hipLaunchKernelGGL(mega_fwd, dim3(grid), dim3(512), LDS_BYTES, stream, a); }
#endif
}
```

```cpp
#include <hip/hip_runtime.h>
#include <hip/hip_cooperative_groups.h>
#include <cstdio>
#include <cstdint>
namespace cg = cooperative_groups;
#ifndef ONE_LAUNCH
#define ONE_LAUNCH 1
#endif
#ifndef PROBE_DUP
#define PROBE_DUP 0
#endif
#ifndef PROBE_ABL
#define PROBE_ABL 0
#endif
__device__ __forceinline__ int my_tid(int wave_s) { int l; asm volatile("v_mbcnt_lo_u32_b32 %0, -1, 0\n\tv_mbcnt_hi_u32_b32 %0, -1, %0" : "=v"(l)); return wave_s * 64 + l; }
namespace pg8 {
#define PG8_LAS __attribute__((address_space(3)))
typedef unsigned short bf16_t;
typedef short bf16x8 __attribute__((ext_vector_type(8)));
typedef float f32x4 __attribute__((ext_vector_type(4)));
typedef unsigned u32x4 __attribute__((ext_vector_type(4)));
constexpr int BM = 256, BK = 64, HALF = 128, HTB = HALF * BK * 2  , STAGE_BYTES = 8 * HTB, NXCD = 8, WGM = 16;

__host__ __device__ __forceinline__ int lds_byte(int r, int c) { const int st = (r >> 4) * 2 + (c >> 5), rr = r & 15, cc = c & 31, ob = rr * 64 + cc * 2; return st * 1024 + (ob ^ (((ob >> 9) & 1) << 5)); }
__host__ __device__ __forceinline__ void stage_rc(int b, int& R, int& C) { const int st = b / 1024, sb = b % 1024, swz = sb ^ (((sb >> 9) & 1) << 5); R = (st >> 1) * 16 + swz / 64; C = (st & 1) * 32 + (swz % 64) / 2; }
__host__ __device__ __forceinline__ int perm32(int rho) { const int n = rho >> 4, i = rho & 15; return 8 * (i >> 2) + 4 * n + (i & 3); }

struct Unit { int pm, pn; };
struct Gemm { const bf16_t* A; const bf16_t* Bt; int M, N, K; };

struct StaticOrder {
    int nM, nN, nwg, G, c;
    __host__ __device__ void init(int M, int N, int G_, int c_) { nM = M / BM; nN = N / BM; nwg = nM * nN; G = G_; c = c_; }
    __host__ __device__ bool next(int i, Unit& u) const {
        const long L = (long)i * G + c; if (L >= nwg) return false;
        int wgid = (int)L; { const int q = nwg / NXCD, r = nwg % NXCD, xcd = wgid % NXCD, off = wgid / NXCD; wgid = (xcd < r ? xcd * (q + 1) : r * (q + 1) + (xcd - r) * q) + off; }
        const int nig = WGM * nN, gid = wgid / nig, fm = gid * WGM, gsz = (nM - fm) < WGM ? (nM - fm) : WGM;
        u.pm = fm + ((wgid % nig) % gsz); u.pn = (wgid % nig) / gsz; return true;
    }
    __device__ __forceinline__ void a_ready(const Unit&) const {}
    __device__ __forceinline__ void done(const Unit&) const {}
};

__device__ __forceinline__ unsigned cvt_pk_bf16(float lo, float hi) { unsigned r; asm volatile("v_cvt_pk_bf16_f32 %0, %1, %2" : "=v"(r) : "v"(lo), "v"(hi)); return r; }
typedef float f32x2 __attribute__((ext_vector_type(2)));
typedef unsigned u32x2 __attribute__((ext_vector_type(2)));
__device__ __forceinline__ float rstd16(const float* p) {
    const f32x4 a = *(const f32x4*)p, b = *(const f32x4*)(p + 4), c = *(const f32x4*)(p + 8), d = *(const f32x4*)(p + 12);
    const float s = (((a[0] + a[1]) + (a[2] + a[3])) + ((b[0] + b[1]) + (b[2] + b[3]))) + (((c[0] + c[1]) + (c[2] + c[3])) + ((d[0] + d[1]) + (d[2] + d[3])));
    return 1.0f / sqrtf(s * (1.0f / 1024.0f) + 1e-6f);
}
struct EpiIn {
    static constexpr bool PERM = true, AFTER_DRAIN = false;
    bf16_t* O; int ldc; int split_cols; size_t split_stride; float qscale; int q_tiles; const float* rowss; float* vss; int v_lo, v_hi; int ug_tiles;
    __device__ __forceinline__ void operator()(const f32x4 (&acc)[2][2][4][2], const Unit& u, int wr, int wc, int fr, int fq) const {
        const int row0 = u.pm * BM + wr * 64 + fr; int colt = u.pn * BM; bf16_t* base = O;
        if (ug_tiles) {
            if (u.pn < ug_tiles) {
                const int colg = u.pn * HALF + wc * 32 + 8 * fq;
#pragma unroll
                for (int ai = 0; ai < 2; ++ai)
#pragma unroll
                    for (int m = 0; m < 4; ++m) { const int row = row0 + ai * HALF + m * 16; const float sc = rowss[row];
                        const f32x4 u0 = acc[ai][0][m][0] * sc, u1 = acc[ai][0][m][1] * sc, g0 = acc[ai][1][m][0] * sc, g1 = acc[ai][1][m][1] * sc; f32x4 r0, r1;
#pragma unroll
                        for (int e_ = 0; e_ < 4; ++e_) { r0[e_] = u0[e_] * g0[e_] * __builtin_amdgcn_rcpf(1.0f + __builtin_amdgcn_exp2f(-1.4426950408889634f * g0[e_])); r1[e_] = u1[e_] * g1[e_] * __builtin_amdgcn_rcpf(1.0f + __builtin_amdgcn_exp2f(-1.4426950408889634f * g1[e_])); }
                        u32x4 w; w.x = cvt_pk_bf16(r0[0], r0[1]); w.y = cvt_pk_bf16(r0[2], r0[3]); w.z = cvt_pk_bf16(r1[0], r1[1]); w.w = cvt_pk_bf16(r1[2], r1[3]);
                        *(u32x4*)(O + (size_t)row * ldc + colg) = w; }
                return;
            }
            base += split_stride; colt = (u.pn - ug_tiles) * BM;
        } else { const int t = colt / split_cols; base += (size_t)t * split_stride; colt -= t * split_cols; }
        const float qs = (u.pn < q_tiles) ? qscale : 1.f;
        const int col0 = colt + wc * 32 + 8 * fq;
        const bool dov = (u.pn >= v_lo && u.pn < v_hi);
#pragma unroll
        for (int ai = 0; ai < 2; ++ai)
#pragma unroll
            for (int m = 0; m < 4; ++m) {
                const int row = row0 + ai * HALF + m * 16; const float sc = rowss[row] * qs; bf16_t* rowp = base + (size_t)row * ldc + col0; float ss = 0.f;
#pragma unroll
                for (int bj = 0; bj < 2; ++bj) { const f32x4 v0 = acc[ai][bj][m][0] * sc, v1 = acc[ai][bj][m][1] * sc;
                    if (dov) ss += ((v0[0] * v0[0] + v0[1] * v0[1]) + (v0[2] * v0[2] + v0[3] * v0[3])) + ((v1[0] * v1[0] + v1[1] * v1[1]) + (v1[2] * v1[2] + v1[3] * v1[3]));
                    u32x4 w; w.x = cvt_pk_bf16(v0[0], v0[1]); w.y = cvt_pk_bf16(v0[2], v0[3]); w.z = cvt_pk_bf16(v1[0], v1[1]); w.w = cvt_pk_bf16(v1[2], v1[3]);
                    *(u32x4*)(rowp + bj * HALF) = w; }
                if (dov) { ss += __shfl_xor(ss, 16); ss += __shfl_xor(ss, 32); if (fq == 0) vss[(size_t)row * 32 + (u.pn - v_lo) * 4 + wc] = ss; }
            }
    }
};
struct EpiVT {
    static constexpr bool PERM = true, AFTER_DRAIN = false;
    bf16_t* O; int ldc; const float* rowss;
    __device__ __forceinline__ void operator()(const f32x4 (&acc)[2][2][4][2], const Unit& u, int wr, int wc, int fr, int fq) const {
        const int row0 = u.pm * BM + wr * 64 + fr; const int col0 = u.pn * BM + wc * 32 + 8 * fq;
        f32x4 cs[2][2];
#pragma unroll
        for (int bj = 0; bj < 2; ++bj)
#pragma unroll
            for (int n = 0; n < 2; ++n)
                cs[bj][n] = *(const f32x4*)(rowss + col0 + bj * HALF + 4 * n);
#pragma unroll
        for (int ai = 0; ai < 2; ++ai)
#pragma unroll
            for (int m = 0; m < 4; ++m) { bf16_t* rowp = O + (size_t)(row0 + ai * HALF + m * 16) * ldc + col0;
#pragma unroll
                for (int bj = 0; bj < 2; ++bj) { const f32x4 v0 = acc[ai][bj][m][0] * cs[bj][0], v1 = acc[ai][bj][m][1] * cs[bj][1];
                    u32x4 w; w.x = cvt_pk_bf16(v0[0], v0[1]); w.y = cvt_pk_bf16(v0[2], v0[3]); w.z = cvt_pk_bf16(v1[0], v1[1]); w.w = cvt_pk_bf16(v1[2], v1[3]);
                    *(u32x4*)(rowp + bj * HALF) = w; } }
    }
};
struct EpiOut {
    static constexpr bool PERM = true, AFTER_DRAIN = false;
    const float* base32; bf16_t* xb; float* rowss; int row_off;
    __device__ __forceinline__ void operator()(const f32x4 (&acc)[2][2][4][2], const Unit& u, int wr, int wc, int fr, int fq) const {
        const int row0 = row_off + u.pm * BM + wr * 64 + fr; const int col0 = u.pn * BM + wc * 32 + 8 * fq;
#pragma unroll
        for (int ai = 0; ai < 2; ++ai)
#pragma unroll
            for (int m = 0; m < 4; ++m) { const int row = row0 + ai * HALF + m * 16; const size_t off = (size_t)row * 1024 + col0; float ss = 0.f;
#pragma unroll
                for (int bj = 0; bj < 2; ++bj) { const size_t o = off + bj * HALF; f32x4 b0, b1;
                    if (base32) { b0 = *(const f32x4*)(base32 + o); b1 = *(const f32x4*)(base32 + o + 4); }
                    else { const u32x4 w = *(const u32x4*)(xb + o);
                        b0[0] = __uint_as_float(w.x << 16); b0[1] = __uint_as_float(w.x & 0xffff0000u); b0[2] = __uint_as_float(w.y << 16); b0[3] = __uint_as_float(w.y & 0xffff0000u);
                        b1[0] = __uint_as_float(w.z << 16); b1[1] = __uint_as_float(w.z & 0xffff0000u); b1[2] = __uint_as_float(w.w << 16); b1[3] = __uint_as_float(w.w & 0xffff0000u); }
                    const f32x4 x0 = b0 + acc[ai][bj][m][0], x1 = b1 + acc[ai][bj][m][1];
                    ss += ((x0[0] * x0[0] + x0[1] * x0[1]) + (x0[2] * x0[2] + x0[3] * x0[3])) + ((x1[0] * x1[0] + x1[1] * x1[1]) + (x1[2] * x1[2] + x1[3] * x1[3]));
                    u32x4 w2; w2.x = cvt_pk_bf16(x0[0], x0[1]); w2.y = cvt_pk_bf16(x0[2], x0[3]); w2.z = cvt_pk_bf16(x1[0], x1[1]); w2.w = cvt_pk_bf16(x1[2], x1[3]);
                    *(u32x4*)(xb + o) = w2; }
                ss += __shfl_xor(ss, 16); ss += __shfl_xor(ss, 32); if (fq == 0) rowss[(size_t)row * 16 + u.pn * 4 + wc] = ss; }
    }
};
template <class Epi, class Sched, bool ALIGN_EPI = false, bool SP2 = false>
__device__ __forceinline__ void gemm_phase(PG8_LAS unsigned char* lds, const Gemm g, const Sched& S, const Epi& E, int wave_s) {
    int tid_l = my_tid(wave_s); const int tid = tid_l, wid = __builtin_amdgcn_readfirstlane(tid >> 6), lane = tid & 63, wr = wid >> 2, wc = wid & 3, fr = lane & 15, fq = lane >> 4;
    const int K = g.K, nt = K / BK;
    unsigned voffA[2], voffB[2];
#pragma unroll
    for (int i = 0; i < 2; ++i) { int R, C; stage_rc(tid * 16 + i * 8192, R, C); const int Rb = Epi::PERM ? ((R & ~31) + perm32(R & 31)) : R;
        voffA[i] = (unsigned)(R * K + C) * 2u; voffB[i] = (unsigned)(Rb * K + C) * 2u; }
    const size_t kstep = (size_t)(BK * 2);
    const size_t hstep = (size_t)HALF * K * 2;
    const size_t tstep = 2 * hstep;
    const unsigned ldsw = (unsigned)wid * 1024u;
    const int aoff = lds_byte(wr * 64 + fr, fq * 8), boff = lds_byte(wc * 32 + fr, fq * 8);
#define PG8_SA(b, h) (((b) * 2 + (h)) * HTB)
#define PG8_SB(b, h) ((4 + (b) * 2 + (h)) * HTB)
    const unsigned ldsb = (unsigned)(uintptr_t)lds + ldsw;
#define PG8_STAGE(bufoff, gbase, voff) do { _Pragma("unroll") for (int _i = 0; _i < 2; ++_i) { unsigned keep_; \
        asm volatile("s_mov_b32 %0, m0\n\ts_mov_b32 m0, %3\n\ts_nop 0\n\tglobal_load_lds_dwordx4 %1, %2\n\ts_mov_b32 m0, %0" : "=&s"(keep_) : "v"((voff)[_i]), "s"((const char*)(gbase)), "s"(ldsb + (unsigned)((bufoff) + _i * 8192)) : "memory"); } } while (0)
#define PG8_LDA(dst, b, h) do { _Pragma("unroll") for (int m = 0; m < 4; ++m) _Pragma("unroll") for (int k = 0; k < 2; ++k) dst[m][k] = *(const PG8_LAS bf16x8*)(lds + PG8_SA(b, h) + aoff + m * 2048 + k * 1024); } while (0)
#define PG8_LDB(dst, b, h) do { _Pragma("unroll") for (int n = 0; n < 2; ++n) _Pragma("unroll") for (int k = 0; k < 2; ++k) dst[n][k] = *(const PG8_LAS bf16x8*)(lds + PG8_SB(b, h) + boff + n * 2048 + k * 1024); } while (0)
#define PG8_MMA(ai, bj, At, Bt) do { __builtin_amdgcn_s_setprio(1); _Pragma("unroll") for (int m = 0; m < 4; ++m) _Pragma("unroll") for (int n = 0; n < 2; ++n) _Pragma("unroll") for (int k = 0; k < 2; ++k) \
        acc[ai][bj][m][n] = __builtin_amdgcn_mfma_f32_16x16x32_bf16(Bt[n][k], At[m][k], acc[ai][bj][m][n], 0, 0, 0); __builtin_amdgcn_s_setprio(0); } while (0)
#define PG8_WAIT_V(n) asm volatile("s_waitcnt vmcnt(" #n ")" ::: "memory")
#define PG8_WAIT_L(n) asm volatile("s_waitcnt lgkmcnt(" #n ")" ::: "memory")
#define PG8_BAR __builtin_amdgcn_s_barrier()
#define PG8_SCHED __builtin_amdgcn_sched_barrier(0)
    Unit cur, nxt; int ui = 0;
    if (!S.next(0, cur)) return;
    f32x4 acc[2][2][4][2];
#pragma unroll
    for (int a = 0; a < 2; ++a)
#pragma unroll
        for (int b = 0; b < 2; ++b)
#pragma unroll
            for (int m = 0; m < 4; ++m)
#pragma unroll
                for (int n = 0; n < 2; ++n) acc[a][b][m][n] = (f32x4){0.f, 0.f, 0.f, 0.f};
    bf16x8 At[4][2], B0[2][2], B1[2][2];
    const char* cA = (const char*)g.A + (size_t)cur.pm * tstep; const char* cB = (const char*)g.Bt + (size_t)cur.pn * tstep;
    S.a_ready(cur);
    if constexpr (SP2) {
        PG8_STAGE(PG8_SB(0, 0), cB, voffB); PG8_STAGE(PG8_SB(0, 1), cB + hstep, voffB); PG8_STAGE(PG8_SA(0, 0), cA, voffA); PG8_STAGE(PG8_SA(0, 1), cA + hstep, voffA);
        if (wr == 1) PG8_BAR;
        PG8_WAIT_V(2); PG8_BAR;
        PG8_STAGE(PG8_SB(1, 0), cB + kstep, voffB); PG8_STAGE(PG8_SA(1, 0), cA + kstep, voffA); PG8_STAGE(PG8_SB(1, 1), cB + hstep + kstep, voffB);
        PG8_WAIT_V(6); PG8_BAR;
    } else {
        PG8_STAGE(PG8_SB(0, 0), cB, voffB); PG8_STAGE(PG8_SA(0, 0), cA, voffA); PG8_STAGE(PG8_SB(0, 1), cB + hstep, voffB); PG8_STAGE(PG8_SA(0, 1), cA + hstep, voffA);
        if (wr == 1) PG8_BAR;
        PG8_WAIT_V(4); PG8_BAR;
        PG8_STAGE(PG8_SB(1, 0), cB + kstep, voffB); PG8_STAGE(PG8_SA(1, 0), cA + kstep, voffA); PG8_STAGE(PG8_SB(1, 1), cB + hstep + kstep, voffB);
        PG8_WAIT_V(6); PG8_BAR;
    }
    for (;;) {
        const bool has_next = S.next(ui + 1, nxt);
        const char* nA = has_next ? (const char*)g.A + (size_t)nxt.pm * tstep : cA; const char* nB = has_next ? (const char*)g.Bt + (size_t)nxt.pn * tstep : cB;
        for (int t = 0; t < nt; t += 2) {
            const bool last = (t == nt - 2);
            const char* a1 = cA + (size_t)(t + 1) * kstep;
            const char* a2 = last ? nA : cA + (size_t)(t + 2) * kstep; const char* b2 = last ? nB : cB + (size_t)(t + 2) * kstep;
            const char* a3 = a2 + kstep; const char* b3 = b2 + kstep;
            if (last && has_next) S.a_ready(nxt);
            if constexpr (SP2) {
            PG8_LDB(B0, 0, 0); PG8_LDB(B1, 0, 1); PG8_SCHED; PG8_LDA(At, 0, 0); PG8_STAGE(PG8_SA(1, 1), a1 + hstep, voffA);
            PG8_WAIT_V(8); PG8_WAIT_L(0); PG8_BAR; PG8_MMA(0, 0, At, B0); PG8_MMA(0, 1, At, B1); PG8_BAR; PG8_SCHED;
            PG8_LDA(At, 0, 1); PG8_STAGE(PG8_SB(0, 0), b2, voffB); PG8_STAGE(PG8_SB(0, 1), b2 + hstep, voffB); PG8_STAGE(PG8_SA(0, 0), a2, voffA);
            PG8_WAIT_V(8); PG8_WAIT_L(0); PG8_BAR; PG8_MMA(1, 0, At, B0); PG8_MMA(1, 1, At, B1); PG8_BAR; PG8_SCHED;
            PG8_LDB(B0, 1, 0); PG8_LDB(B1, 1, 1); PG8_SCHED; PG8_LDA(At, 1, 0); PG8_STAGE(PG8_SA(0, 1), a2 + hstep, voffA);
            PG8_WAIT_V(8); PG8_WAIT_L(0); PG8_BAR; PG8_MMA(0, 0, At, B0); PG8_MMA(0, 1, At, B1); PG8_BAR; PG8_SCHED;
            PG8_LDA(At, 1, 1); PG8_STAGE(PG8_SB(1, 0), b3, voffB); PG8_STAGE(PG8_SB(1, 1), b3 + hstep, voffB); PG8_STAGE(PG8_SA(1, 0), a3, voffA);
            PG8_WAIT_V(8); PG8_WAIT_L(0); PG8_BAR; PG8_MMA(1, 0, At, B0); PG8_MMA(1, 1, At, B1); PG8_BAR; PG8_SCHED;
            } else {
            PG8_LDB(B0, 0, 0); PG8_SCHED; PG8_LDA(At, 0, 0); PG8_STAGE(PG8_SA(1, 1), a1 + hstep, voffA);
            PG8_WAIT_L(8); PG8_BAR; PG8_WAIT_L(0); PG8_MMA(0, 0, At, B0); PG8_BAR; PG8_SCHED;
            PG8_LDB(B1, 0, 1); PG8_STAGE(PG8_SB(0, 0), b2, voffB);
            PG8_BAR; PG8_WAIT_L(0); PG8_MMA(0, 1, At, B1); PG8_BAR;
            PG8_LDA(At, 0, 1); PG8_STAGE(PG8_SA(0, 0), a2, voffA);
            PG8_BAR; PG8_WAIT_L(0); PG8_MMA(1, 0, At, B0); PG8_BAR; PG8_SCHED;
            PG8_STAGE(PG8_SB(0, 1), b2 + hstep, voffB);
            PG8_WAIT_V(6); PG8_BAR; PG8_MMA(1, 1, At, B1); PG8_BAR;
            PG8_LDB(B0, 1, 0); PG8_SCHED; PG8_LDA(At, 1, 0); PG8_STAGE(PG8_SA(0, 1), a2 + hstep, voffA);
            PG8_WAIT_L(8); PG8_BAR; PG8_WAIT_L(0); PG8_MMA(0, 0, At, B0); PG8_BAR; PG8_SCHED;
            PG8_LDB(B1, 1, 1); PG8_STAGE(PG8_SB(1, 0), b3, voffB);
            PG8_BAR; PG8_WAIT_L(0); PG8_MMA(0, 1, At, B1); PG8_BAR;
            PG8_LDA(At, 1, 1); PG8_STAGE(PG8_SA(1, 0), a3, voffA);
            PG8_BAR; PG8_WAIT_L(0); PG8_MMA(1, 0, At, B0); PG8_BAR; PG8_SCHED;
            PG8_STAGE(PG8_SB(1, 1), b3 + hstep, voffB);
            PG8_WAIT_V(6); PG8_BAR; PG8_MMA(1, 1, At, B1); PG8_BAR;
            }
        }
        if constexpr (ALIGN_EPI) { if (wr == 0) PG8_BAR; }
        if constexpr (!Epi::AFTER_DRAIN) { E(acc, cur, wr, wc, fr, fq); S.done(cur); }
        if (!has_next) break;
#pragma unroll
        for (int a = 0; a < 2; ++a)
#pragma unroll
            for (int b = 0; b < 2; ++b)
#pragma unroll
                for (int m = 0; m < 4; ++m)
#pragma unroll
                    for (int n = 0; n < 2; ++n) acc[a][b][m][n] = (f32x4){0.f, 0.f, 0.f, 0.f};
        cur = nxt; cA = nA; cB = nB; ++ui;
        if constexpr (ALIGN_EPI) { if (wr == 1) PG8_BAR; }
    }
    PG8_WAIT_V(0);
    if constexpr (!ALIGN_EPI) { if (wr == 0) PG8_BAR; }
    PG8_BAR;
    if constexpr (Epi::AFTER_DRAIN) { E.fused(acc, cur, wr, wc, fr, fq, lds, wid, lane); S.done(cur); }
#undef PG8_SA
#undef PG8_SB
#undef PG8_STAGE
#undef PG8_LDA
#undef PG8_LDB
#undef PG8_MMA
#undef PG8_WAIT_V
#undef PG8_WAIT_L
#undef PG8_BAR
#undef PG8_SCHED
}
}
#define LAS __attribute__((address_space(3)))
typedef unsigned short bf16;
typedef short bf16x8 __attribute__((ext_vector_type(8)));
typedef float f32x16 __attribute__((ext_vector_type(16)));
typedef float f32x4 __attribute__((ext_vector_type(4)));
typedef unsigned u32x4 __attribute__((ext_vector_type(4)));
typedef unsigned u32x2 __attribute__((ext_vector_type(2)));
typedef float f32x2_t __attribute__((ext_vector_type(2))); typedef __bf16 bf16x2_t __attribute__((ext_vector_type(2)));
constexpr int DM = 1024, SEQ = 4096, MTOK = 32768, HTOK = 16384, BR = 2048, NHEAD = 16;
constexpr size_t MiB = 1u << 20;
constexpr size_t WS_ROWSS = 1 * MiB;
constexpr size_t WS_VSS = 3 * MiB;
constexpr size_t WS_RSTD = 6 * MiB;
constexpr size_t WS_WM = 5 * MiB;
constexpr size_t WS_W = 8 * MiB;
constexpr size_t W_ATT_IN = 0, W_ATT_OUT = 32 * MiB, W_SGU_IN = 40 * MiB, W_SGU_OUT = 64 * MiB;
constexpr size_t WS_XB = 80 * MiB;
constexpr size_t WS_ACT = 144 * MiB;
constexpr size_t ACT_STRIDE = (size_t)HTOK * BR;
constexpr size_t WS_END = 400 * MiB;
constexpr int RING_BYTES = 131072, LDS_BYTES = 147456;
constexpr float LOG2E = 1.4426950408889634f;
constexpr float QSCALE = 0.125f * LOG2E;
constexpr int NPHASE = 19;

__device__ __forceinline__ float bf2f(unsigned short b) { return __uint_as_float((unsigned)b << 16); }
__device__ __forceinline__ unsigned pk2(float lo, float hi) { f32x2_t v = {lo, hi}; bf16x2_t b = __builtin_convertvector(v, bf16x2_t); return __builtin_bit_cast(unsigned, b); }
__device__ __forceinline__ float wave_sum(float v) {
#pragma unroll
    for (int o = 1; o < 64; o <<= 1) v += __shfl_xor(v, o);
    return v;
}
__device__ __forceinline__ float swap_max(float m) { auto rr = __builtin_amdgcn_permlane32_swap(__float_as_uint(m), __float_as_uint(m), false, false); return fmaxf(__uint_as_float(rr[0]), __uint_as_float(rr[1])); }
__device__ __forceinline__ float swap_sum(float m) { auto rr = __builtin_amdgcn_permlane32_swap(__float_as_uint(m), __float_as_uint(m), false, false); return __uint_as_float(rr[0]) + __uint_as_float(rr[1]); }
__device__ __forceinline__ float silu_f(float x) { return x * __builtin_amdgcn_rcpf(1.0f + __builtin_amdgcn_exp2f(-LOG2E * x)); }
__device__ __forceinline__ int crow(int r, int hi) { return (r & 3) + 8 * (r >> 2) + 4 * hi; }
__device__ __forceinline__ float fadd_s(float a, float b) { float r; asm("v_add_f32_e32 %0, %1, %2" : "=v"(r) : "v"(a), "v"(b)); return r; }
__device__ __forceinline__ float max3f_s(float a, float b, float c) { float r; asm("v_max3_f32 %0, %1, %2, %3" : "=v"(r) : "v"(a), "v"(b), "v"(c)); return r; }
__device__ __forceinline__ float max2f_s(float a, float b) { float r; asm("v_max_f32_e32 %0, %1, %2" : "=v"(r) : "v"(a), "v"(b)); return r; }
#define MFMA32(a, b, c) __builtin_amdgcn_mfma_f32_32x32x16_bf16((a), (b), (c), 0, 0, 0)

struct Args { const float* in[17]; float* out; unsigned char* ws; int ph_lo, ph_hi, pad0, pad1; };

__device__ __forceinline__ void transpose_item(const float* W, const float* gain, int K, int N, bf16* WT, int n0, int dst_row0, int k0, LAS float* scr, int lane) {
#pragma unroll
    for (int i = 0; i < 32; ++i) { const int kk = 2 * i + (lane >> 5); const float gv = gain ? gain[k0 + kk] : 1.f; scr[kk * 33 + (lane & 31)] = W[(size_t)(k0 + kk) * N + n0 + (lane & 31)] * gv; }
    asm volatile("s_waitcnt lgkmcnt(0)" ::: "memory");
    const int c = lane & 7;
#pragma unroll
    for (int j = 0; j < 4; ++j) { const int n = (lane >> 3) + 8 * j; const LAS float* s = scr + (8 * c) * 33 + n;
        u32x4 o; o.x = pk2(s[0 * 33], s[1 * 33]); o.y = pk2(s[2 * 33], s[3 * 33]); o.z = pk2(s[4 * 33], s[5 * 33]); o.w = pk2(s[6 * 33], s[7 * 33]);
        *(u32x4*)(WT + (size_t)(dst_row0 + n) * K + k0 + 8 * c) = o; }
    asm volatile("s_waitcnt lgkmcnt(0)" ::: "memory");
}
__device__ __forceinline__ void prologue(const Args& a, LAS unsigned char* lds, int vcu, int G, int wave_s) {
    int tid_l = my_tid(wave_s); const int tid = tid_l, lane = tid & 63, wave = __builtin_amdgcn_readfirstlane(tid >> 6);
    LAS float* scr = (LAS float*)(lds + wave * 16384);
    const int gw = vcu * 8 + wave, NGW = G * 8;
    bf16* wbase = (bf16*)(a.ws + WS_W);
    constexpr int I_AI = 16 * 256, I_AO = 32 * 32, I_SI = 16 * 192, I_SO = 32 * 32, I_J = I_AI + I_AO + I_SI + I_SO;
    for (int it = gw; it < 2 * I_J; it += NGW) {
        const int j = it / I_J; int r = it % I_J;
        if (r < I_AI) { const int kb = r / 256, nb = r % 256, n0 = nb * 32; const int dr = n0 < 4096 ? n0 : (n0 < 6144 ? n0 + 2048 : n0 - 2048);
            transpose_item(a.in[3] + (size_t)j * 1024 * 8192, a.in[2] + j * 1024, 1024, 8192, wbase + (W_ATT_IN + (size_t)j * 16 * MiB) / 2, n0, dr, kb * 64, scr, lane); continue; } r -= I_AI;
        if (r < I_AO) { const int kb = r / 32, nb = r % 32;
            transpose_item(a.in[9] + (size_t)j * 2048 * 1024, nullptr, 2048, 1024, wbase + (W_ATT_OUT + (size_t)j * 4 * MiB) / 2, nb * 32, nb * 32, kb * 64, scr, lane); continue; } r -= I_AO;
        if (r < I_SI) { const int kb = r / 192, nb = r % 192, n0 = nb * 32;
            const int dr = n0 < 2048 ? (n0 >> 7) * 256 + (n0 & 127) : (n0 < 4096 ? n0 + 2048 : ((n0 - 4096) >> 7) * 256 + 128 + (n0 & 127));
            transpose_item(a.in[11] + (size_t)j * 1024 * 6144, a.in[10] + j * 1024, 1024, 6144, wbase + (W_SGU_IN + (size_t)j * 12 * MiB) / 2, n0, dr, kb * 64, scr, lane); continue; } r -= I_SI;
        { const int kb = r / 32, nb = r % 32;
            transpose_item(a.in[15] + (size_t)j * 2048 * 1024, nullptr, 2048, 1024, wbase + (W_SGU_OUT + (size_t)j * 4 * MiB) / 2, nb * 32, nb * 32, kb * 64, scr, lane); }
    }
    const float* x = a.in[0]; bf16* xb = (bf16*)(a.ws + WS_XB); float* rstdc = (float*)(a.ws + WS_RSTD);
    for (int m0 = gw * 4; m0 < MTOK; m0 += NGW * 4) {
        f32x4 v[4][4];
#pragma unroll
        for (int q = 0; q < 4; ++q) { const f32x4* xr = (const f32x4*)(x + (size_t)(m0 + q) * DM) + lane;
#pragma unroll
            for (int j = 0; j < 4; ++j) v[q][j] = xr[64 * j]; }
#pragma unroll
        for (int q = 0; q < 4; ++q) { const int m = m0 + q; float s = 0.f;
#pragma unroll
            for (int j = 0; j < 4; ++j) s += (v[q][j][0] * v[q][j][0] + v[q][j][1] * v[q][j][1]) + (v[q][j][2] * v[q][j][2] + v[q][j][3] * v[q][j][3]);
            s = wave_sum(s);
            u32x2* o8 = (u32x2*)(xb + (size_t)m * DM) + lane;
#pragma unroll
            for (int j = 0; j < 4; ++j) { u32x2 w; w.x = pk2(v[q][j][0], v[q][j][1]); w.y = pk2(v[q][j][2], v[q][j][3]); o8[64 * j] = w; }
            if (lane == 0) rstdc[m] = 1.0f / sqrtf(s * (1.0f / 1024.0f) + 1e-6f); }
    }
    const float* wsrc = a.in[13]; bf16* wm = (bf16*)(a.ws + WS_WM);
    for (int i = vcu * 512 + tid; i < 2 * 16 * 128 * 128 / 4; i += G * 512) {
        const f32x4 w = *((const f32x4*)wsrc + i); const int e = i * 4, s = e & 127, t = (e >> 7) & 127;
        u32x2 o; o.x = pk2(s <= t ? w[0] : 0.f, s + 1 <= t ? w[1] : 0.f); o.y = pk2(s + 2 <= t ? w[2] : 0.f, s + 3 <= t ? w[3] : 0.f);
        *((u32x2*)wm + i) = o;
    }
}

namespace att {
constexpr int KST = 16384, VST = 16384, NSK = 3, NSV = 3;
constexpr int OFF_K = 0, OFF_V = NSK * KST, OFF_OSTG = 65536, OSTG_W = 32 * 272, OFF_TB = 102400, TBC = 324, OFF_END = OFF_TB + 512 + 4 * TBC * 4;
static_assert(OFF_END <= RING_BYTES && OFF_OSTG + 4 * OSTG_W <= OFF_TB && OFF_V + NSV * VST <= OFF_TB, "attention LDS map");
}
#define SGB(mask, n) __builtin_amdgcn_sched_group_barrier((mask), (n), 0)
template <int ABL> __device__ __forceinline__ void attn_unit(LAS unsigned char* lds, const bf16* Qb, bf16* Yb, const bf16* Kb, const bf16* Gb, const bf16* VTb, const float* rel_bias, const float* subln, float lam, float c1, int bl, int h, int qb, int wave_s) {
    using namespace att;
    int tid_l = my_tid(wave_s); const int tid = tid_l, lane = tid & 63, r32 = lane & 31, hi = lane >> 5;
    const int wid = __builtin_amdgcn_readfirstlane(tid >> 6), mp = wid >> 2, wq = wid & 3;
    const int rowbase = bl * SEQ, q0 = qb * 128, wfirst = q0 + 32 * wq;
    LAS float* sg = (LAS float*)(lds + OFF_TB); LAS float* tbl = sg + 128;
    if (tid < 128) sg[tid] = subln[tid];
    { const float b31 = rel_bias[31 * 16 + h];
      for (int idx = tid; idx < 4 * TBC; idx += 512) { const int c_ = idx / TBC, i_ = idx % TBC + c_, n = 223 - i_; float v = 0.f;
        if (n < 0) v = -INFINITY;
        else if (n < 113) { int bk = n; if (n >= 16) bk = 16 + (n >= 19) + (n >= 21) + (n >= 24) + (n >= 27) + (n >= 31) + (n >= 35) + (n >= 40) + (n >= 46) + (n >= 52) + (n >= 59) + (n >= 67) + (n >= 77) + (n >= 87) + (n >= 99);
            v = (rel_bias[bk * 16 + h] - b31) * LOG2E; }
        tbl[idx] = v; } }
    const int nt = 2 * (qb + 1);
    const int krow_l = 4 * wid + (lane >> 4), kchunk = (lane & 15) ^ (krow_l & 15);
    const bf16* ksrc = Kb + (size_t)(rowbase + krow_l) * BR + h * 128 + kchunk * 8;
    const int vdv_l = 8 * wid + (lane >> 3), vchunk = (lane & 7) ^ ((vdv_l >> 1) & 7);
    const bf16* vsrc = VTb + (size_t)(h * 128 + vdv_l) * HTOK + rowbase + vchunk * 8;
#define ATT_DMAK(t, sk) do { _Pragma("unroll") for (int i_ = 0; i_ < 2; ++i_) \
        __builtin_amdgcn_global_load_lds((const unsigned*)(ksrc + (size_t)(64 * (t) + 32 * i_) * BR), (LAS unsigned*)(lds + OFF_K + (sk) * KST + (wid + 8 * i_) * 1024), 16, 0, 0); } while (0)
#define ATT_DMAV(t, sv) do { _Pragma("unroll") for (int i_ = 0; i_ < 2; ++i_) \
        __builtin_amdgcn_global_load_lds((const unsigned*)(vsrc + (size_t)(64 * i_) * HTOK + 64 * (t)), (LAS unsigned*)(lds + OFF_V + (sv) * VST + (wid + 8 * i_) * 1024), 16, 0, 0); } while (0)
#define DMAK1(t, sk, i_) do { if ((t) < nt) __builtin_amdgcn_global_load_lds((const unsigned*)(ksrc + (size_t)(64 * (t) + 32 * (i_)) * BR), (LAS unsigned*)(lds + OFF_K + (sk) * KST + (wid + 8 * (i_)) * 1024), 16, 0, 0); } while (0)
#define DMAV1(t, sv, i_) do { if ((t) < nt) __builtin_amdgcn_global_load_lds((const unsigned*)(vsrc + (size_t)(64 * (i_)) * HTOK + 64 * (t)), (LAS unsigned*)(lds + OFF_V + (sv) * VST + (wid + 8 * (i_)) * 1024), 16, 0, 0); } while (0)
    ATT_DMAK(0, 0); ATT_DMAK(1, 1); ATT_DMAV(0, 0); if (nt > 2) ATT_DMAK(2, 2); ATT_DMAV(1, 1);
    bf16x8 qf[4];
    { const bf16* qp = Qb + (size_t)(rowbase + wfirst + r32) * BR + h * 128 + mp * 64 + hi * 8;
#pragma unroll
      for (int c = 0; c < 4; ++c) qf[c] = *(const bf16x8*)(qp + 16 * c); }
    const int pirow = (r32 & ~12) | ((r32 & 4) << 1) | ((r32 & 8) >> 1);
    int kaddr[4], vaddr[4];
#pragma unroll
    for (int c = 0; c < 4; ++c) { kaddr[c] = OFF_K + pirow * 256 + (((mp * 8 + 2 * c + hi) ^ (pirow & 15)) << 4); vaddr[c] = OFF_V + r32 * 128 + (((2 * c + hi) ^ ((r32 >> 1) & 7)) << 4); }
    float mu = 0.f, l = 0.f; f32x16 o[4], negm;
#pragma unroll
    for (int r = 0; r < 16; ++r) { o[0][r] = 0.f; o[1][r] = 0.f; o[2][r] = 0.f; o[3][r] = 0.f; }
    const int nact = min(nt, (wfirst + 31) / 64 + 1);
#define ATT_NEAR(x0, x1, tt) do { if (64 * (tt) + 63 + 113 > wfirst) { const int i0_ = 223 - (wfirst + r32 - 64 * (tt) - 8 * hi), c_ = i0_ & 3; const LAS float* tp_ = tbl + c_ * TBC + (i0_ - c_); f32x4 b_; \
        b_ = *(const LAS f32x4*)(tp_);      x0[0] += b_[0]; x0[1] += b_[1]; x0[2] += b_[2]; x0[3] += b_[3];     b_ = *(const LAS f32x4*)(tp_ + 4);  x0[4] += b_[0]; x0[5] += b_[1]; x0[6] += b_[2]; x0[7] += b_[3]; \
        b_ = *(const LAS f32x4*)(tp_ + 16); x0[8] += b_[0]; x0[9] += b_[1]; x0[10] += b_[2]; x0[11] += b_[3];  b_ = *(const LAS f32x4*)(tp_ + 20); x0[12] += b_[0]; x0[13] += b_[1]; x0[14] += b_[2]; x0[15] += b_[3]; \
        b_ = *(const LAS f32x4*)(tp_ + 32); x1[0] += b_[0]; x1[1] += b_[1]; x1[2] += b_[2]; x1[3] += b_[3];     b_ = *(const LAS f32x4*)(tp_ + 36); x1[4] += b_[0]; x1[5] += b_[1]; x1[6] += b_[2]; x1[7] += b_[3]; \
        b_ = *(const LAS f32x4*)(tp_ + 48); x1[8] += b_[0]; x1[9] += b_[1]; x1[10] += b_[2]; x1[11] += b_[3];  b_ = *(const LAS f32x4*)(tp_ + 52); x1[12] += b_[0]; x1[13] += b_[1]; x1[14] += b_[2]; x1[15] += b_[3]; } } while (0)
#define ATT_ROWMAX(x0, x1, mx) do { mx = fmaxf(fmaxf(x0[0], x1[0]), fmaxf(x0[1], x1[1])); \
        _Pragma("unroll") for (int r = 2; r < 16; r += 2) mx = fmaxf(fmaxf(mx, x0[r]), fmaxf(x1[r], fmaxf(x0[r + 1], x1[r + 1]))); mx = swap_max(mx); } while (0)
    bf16x8 pb[4], pc[4];
#pragma unroll
    for (int c = 0; c < 4; ++c) pc[c] = (bf16x8){0, 0, 0, 0, 0, 0, 0, 0};
    asm volatile("s_waitcnt vmcnt(6)" ::: "memory"); __builtin_amdgcn_s_barrier(); asm volatile("" ::: "memory");
    {
        f32x16 s0, s1;
#pragma unroll
        for (int r = 0; r < 16; ++r) { s0[r] = 0.f; s1[r] = 0.f; }
        bf16x8 kf[8];
#pragma unroll
        for (int c = 0; c < 4; ++c) { kf[2 * c] = *(const LAS bf16x8*)(lds + kaddr[c]); kf[2 * c + 1] = *(const LAS bf16x8*)(lds + kaddr[c] + 8192); }
#pragma unroll
        for (int c = 0; c < 4; ++c) { s0 = MFMA32(kf[2 * c], qf[c], s0); s1 = MFMA32(kf[2 * c + 1], qf[c], s1); }
        ATT_NEAR(s0, s1, 0);
        float mx; ATT_ROWMAX(s0, s1, mx);
        mu = mx; float sum = 0.f;
#pragma unroll
        for (int r = 0; r < 16; ++r) { negm[r] = -mx; s0[r] = __builtin_amdgcn_exp2f(s0[r] - mx); s1[r] = __builtin_amdgcn_exp2f(s1[r] - mx); sum += s0[r] + s1[r]; }
        l = sum;
        u32x4 w;
        w.x = pk2(s0[0], s0[1]); w.y = pk2(s0[2], s0[3]); w.z = pk2(s0[4], s0[5]); w.w = pk2(s0[6], s0[7]); pb[0] = __builtin_bit_cast(bf16x8, w);
        w.x = pk2(s0[8], s0[9]); w.y = pk2(s0[10], s0[11]); w.z = pk2(s0[12], s0[13]); w.w = pk2(s0[14], s0[15]); pb[1] = __builtin_bit_cast(bf16x8, w);
        w.x = pk2(s1[0], s1[1]); w.y = pk2(s1[2], s1[3]); w.z = pk2(s1[4], s1[5]); w.w = pk2(s1[6], s1[7]); pb[2] = __builtin_bit_cast(bf16x8, w);
        w.x = pk2(s1[8], s1[9]); w.y = pk2(s1[10], s1[11]); w.z = pk2(s1[12], s1[13]); w.w = pk2(s1[14], s1[15]); pb[3] = __builtin_bit_cast(bf16x8, w);
    }
    int sk1 = 1, sk3 = 0, sv0 = 0, sv2 = 2;
#define SBAR() __builtin_amdgcn_sched_barrier(0)
#define VLD(i) (*(const LAS bf16x8*)(vs_ + vaddr[(i) >> 2] + ((i) & 3) * 4096))
#define PVG(i, EXPS) do { o[(i) & 3] = MFMA32(vf[(i) % 4], PBI_[(i) >> 2], o[(i) & 3]); if ((i) + 4 < 16) vf[(i) % 4] = VLD((i) + 4); EXPS; SBAR(); } while (0)
#define EXG(nn, r, W, C) do { const float a_ = __builtin_amdgcn_exp2f(nn[r]), b_ = __builtin_amdgcn_exp2f(nn[r + 1]); sum = fadd_s(sum, a_); sumb = fadd_s(sumb, b_); W.C = pk2(a_, b_); asm volatile("" : "+v"(sum), "+v"(sumb), "+v"(W.C)); } while (0)
#define KLD(i) (*(const LAS bf16x8*)(ks + kaddr[(i) >> 1] + ((i) & 1) * 8192))
#define ATT_ITER(T_, PBIN, PBO_) do { bf16x8 (&PBI_)[4] = PBIN; \
        if (T_ + 2 < nt) asm volatile("s_waitcnt vmcnt(4)" ::: "memory"); else if (T_ + 1 < nt) asm volatile("s_waitcnt vmcnt(2)" ::: "memory"); else asm volatile("s_waitcnt vmcnt(0)" ::: "memory"); \
        __builtin_amdgcn_s_barrier(); asm volatile("" ::: "memory"); \
        if (T_ >= nact) { if (T_ + 3 < nt) ATT_DMAK(T_ + 3, sk3); if (T_ + 2 < nt) ATT_DMAV(T_ + 2, sv2); } \
        if (T_ < nact) { \
            const LAS unsigned char* vs_ = lds + sv0 * VST; \
            if (T_ + 1 < nact) { \
                const LAS unsigned char* ks = lds + sk1 * KST; \
                bf16x8 kf[4]; f32x16 n0, n1; float sum = 0.f, sumb = 0.f; u32x4 w0, w1, w2, w3; float alpha = 1.f; \
                kf[0] = KLD(0); kf[1] = KLD(1); kf[2] = KLD(2); SBAR(); \
                n0 = MFMA32(kf[0], qf[0], negm); kf[3] = KLD(3); SBAR(); \
                n1 = MFMA32(kf[1], qf[0], negm); kf[0] = KLD(4); SBAR(); \
                n0 = MFMA32(kf[2], qf[1], n0); kf[1] = KLD(5); SBAR(); \
                n1 = MFMA32(kf[3], qf[1], n1); kf[2] = KLD(6); SBAR(); \
                n0 = MFMA32(kf[0], qf[2], n0); kf[3] = KLD(7); SBAR(); \
                n1 = MFMA32(kf[1], qf[2], n1); SBAR(); \
                n0 = MFMA32(kf[2], qf[3], n0); SBAR(); \
                n1 = MFMA32(kf[3], qf[3], n1); \
                bf16x8 vf[4]; vf[0] = VLD(0); vf[1] = VLD(1); vf[2] = VLD(2); vf[3] = VLD(3); SBAR(); \
                ATT_NEAR(n0, n1, T_ + 1); \
                SBAR(); \
                PVG(0, EXG(n0, 0, w0, x)); PVG(1, EXG(n0, 2, w0, y); DMAK1(T_ + 3, sk3, 0)); PVG(2, EXG(n0, 4, w0, z)); PVG(3, EXG(n0, 6, w0, w)); \
                PVG(4, EXG(n0, 8, w1, x)); PVG(5, EXG(n0, 10, w1, y); DMAK1(T_ + 3, sk3, 1)); PVG(6, EXG(n0, 12, w1, z)); PVG(7, EXG(n0, 14, w1, w)); \
                PVG(8, EXG(n1, 0, w2, x)); PVG(9, EXG(n1, 2, w2, y); DMAV1(T_ + 2, sv2, 0)); PVG(10, EXG(n1, 4, w2, z)); PVG(11, EXG(n1, 6, w2, w)); \
                PVG(12, EXG(n1, 8, w3, x)); PVG(13, EXG(n1, 10, w3, y); DMAV1(T_ + 2, sv2, 1)); PVG(14, EXG(n1, 12, w3, z)); PVG(15, EXG(n1, 14, w3, w)); \
                float tot_ = sum + sumb; \
                if (__any(!(tot_ <= 4096.0f))) { \
                    float mx; ATT_ROWMAX(n0, n1, mx); \
                    const float dl = mx > 8.0f ? mx : 0.f; mu += dl; alpha = __builtin_amdgcn_exp2f(-dl); l *= alpha; \
                    float s2_ = 0.f; \
_Pragma("unroll") \
                    for (int r = 0; r < 16; ++r) { n0[r] = __builtin_amdgcn_exp2f(n0[r] - dl); n1[r] = __builtin_amdgcn_exp2f(n1[r] - dl); s2_ += n0[r] + n1[r]; negm[r] = -mu; \
                        o[0][r] *= alpha; o[1][r] *= alpha; o[2][r] *= alpha; o[3][r] *= alpha; } \
                    tot_ = s2_; \
                    w0.x = pk2(n0[0], n0[1]); w0.y = pk2(n0[2], n0[3]); w0.z = pk2(n0[4], n0[5]); w0.w = pk2(n0[6], n0[7]); \
                    w1.x = pk2(n0[8], n0[9]); w1.y = pk2(n0[10], n0[11]); w1.z = pk2(n0[12], n0[13]); w1.w = pk2(n0[14], n0[15]); \
                    w2.x = pk2(n1[0], n1[1]); w2.y = pk2(n1[2], n1[3]); w2.z = pk2(n1[4], n1[5]); w2.w = pk2(n1[6], n1[7]); \
                    w3.x = pk2(n1[8], n1[9]); w3.y = pk2(n1[10], n1[11]); w3.z = pk2(n1[12], n1[13]); w3.w = pk2(n1[14], n1[15]); \
                } \
                l += tot_; \
                PBO_[0] = __builtin_bit_cast(bf16x8, w0); PBO_[1] = __builtin_bit_cast(bf16x8, w1); PBO_[2] = __builtin_bit_cast(bf16x8, w2); PBO_[3] = __builtin_bit_cast(bf16x8, w3); \
            } else { \
                bf16x8 vf[4]; vf[0] = VLD(0); vf[1] = VLD(1); vf[2] = VLD(2); vf[3] = VLD(3); SBAR(); \
                PVG(0, (void)0); PVG(1, DMAK1(T_ + 3, sk3, 0)); PVG(2, (void)0); PVG(3, (void)0); PVG(4, (void)0); PVG(5, DMAK1(T_ + 3, sk3, 1)); PVG(6, (void)0); PVG(7, (void)0); \
                PVG(8, (void)0); PVG(9, DMAV1(T_ + 2, sv2, 0)); PVG(10, (void)0); PVG(11, (void)0); PVG(12, (void)0); PVG(13, DMAV1(T_ + 2, sv2, 1)); PVG(14, (void)0); PVG(15, (void)0); \
            } \
        } \
        sk1 = (sk1 == 2) ? 0 : sk1 + 1; sk3 = (sk3 == 2) ? 0 : sk3 + 1; sv0 = (sv0 == 2) ? 0 : sv0 + 1; sv2 = (sv2 == 2) ? 0 : sv2 + 1; \
    } while (0)
#pragma unroll 1
    for (int t = 0; t < (ABL == 5 ? 0 : nt); t += 2) { ATT_ITER(t, pb, pc); ATT_ITER(t + 1, pc, pb); }
#undef ATT_ITER
#undef KLD
#undef SBAR
#undef VLD
#undef PVG
#undef EXG
#undef ATT_DMAK
#undef DMAK1
#undef DMAV1
#undef ATT_DMAV
#undef ATT_NEAR
#undef ATT_ROWMAX
    asm volatile("s_waitcnt vmcnt(0) lgkmcnt(0)" ::: "memory"); __builtin_amdgcn_s_barrier(); asm volatile("" ::: "memory");
    const float inv = 1.0f / swap_sum(l);
    u32x4 gpre[8];
    if (mp == 0) {
#pragma unroll
        for (int i = 0; i < 8; ++i) { const int p = lane + 64 * i, row = p >> 4, ch = p & 15; gpre[i] = *(const u32x4*)(Gb + (size_t)(rowbase + wfirst + row) * BR + h * 128 + ch * 8); }
    }
    LAS float* oc = (LAS float*)lds + wq * 4096 + lane;
    if (mp == 1) {
#pragma unroll
        for (int b = 0; b < 4; ++b)
#pragma unroll
            for (int r = 0; r < 16; ++r) oc[(b * 16 + r) * 64] = o[b][r] * inv;
    }
    __syncthreads();
    if (mp == 0) {
        float ss = 0.f;
#pragma unroll
        for (int b = 0; b < 4; ++b)
#pragma unroll
            for (int r = 0; r < 16; ++r) { const float d = o[b][r] * inv - lam * oc[(b * 16 + r) * 64]; o[b][r] = d; ss += d * d; }
        ss = swap_sum(ss);
        const float rs = c1 / sqrtf(ss * (1.0f / 128.0f) + 1e-6f);
        LAS unsigned char* stg = lds + OFF_OSTG + wq * OSTG_W;
#pragma unroll
        for (int b = 0; b < 4; ++b)
#pragma unroll
            for (int g4 = 0; g4 < 4; ++g4) { const int dv0 = 32 * b + 8 * g4 + 4 * hi; const f32x4 gg = *(const LAS f32x4*)(sg + dv0);
                u32x2 w; w.x = pk2(o[b][4 * g4] * rs * gg[0], o[b][4 * g4 + 1] * rs * gg[1]); w.y = pk2(o[b][4 * g4 + 2] * rs * gg[2], o[b][4 * g4 + 3] * rs * gg[3]);
                *(LAS u32x2*)(stg + r32 * 272 + dv0 * 2) = w; }
        asm volatile("s_waitcnt lgkmcnt(0)" ::: "memory");
#pragma unroll
        for (int i = 0; i < 8; ++i) { const int p = lane + 64 * i, row = p >> 4, ch = p & 15;
            const u32x4 ov = *(const LAS u32x4*)(stg + row * 272 + ch * 16);
            const size_t goff = (size_t)(rowbase + wfirst + row) * BR + h * 128 + ch * 8;
            const u32x4 gv = gpre[i]; u32x4 y;
#pragma unroll
            for (int e = 0; e < 4; ++e) { const float o0 = __uint_as_float(ov[e] << 16), o1 = __uint_as_float(ov[e] & 0xffff0000u), g0 = __uint_as_float(gv[e] << 16), g1 = __uint_as_float(gv[e] & 0xffff0000u);
                y[e] = pk2(o0 * silu_f(g0), o1 * silu_f(g1)); }
            *(u32x4*)(Yb + goff) = y; }
    }
    __syncthreads();
}

struct SguV { f32x4 vq[8]; u32x4 va[2], vb2[2]; bf16x8 af[8]; };
__device__ __forceinline__ void sgu_issue_v(SguV& S, const bf16* Vb, const float* vss, const bf16* Wm, int row0, int g, int tid) {
    const int lane = tid & 63, r32 = lane & 31, hi = lane >> 5; const int wid = __builtin_amdgcn_readfirstlane(tid >> 6), tbk = wid & 3;
    { const f32x4* p = (const f32x4*)(vss + (size_t)(row0 + (tid & 127)) * 32);
#pragma unroll
      for (int i = 0; i < 8; ++i) S.vq[i] = p[i]; }
#pragma unroll
    for (int i = 0; i < 2; ++i) { const int p = tid + 512 * i, sp = p & 63, chk = p >> 6, s = 2 * sp;
        S.va[i] = *(const u32x4*)(Vb + (size_t)(row0 + s) * BR + g * 128 + chk * 8); S.vb2[i] = *(const u32x4*)(Vb + (size_t)(row0 + s + 1) * BR + g * 128 + chk * 8); }
    const bf16* wrow = Wm + (size_t)(g * 128 + 32 * tbk + r32) * 128 + 8 * hi;
#pragma unroll
    for (int c = 0; c < 8; ++c) S.af[c] = *(const bf16x8*)(wrow + 16 * c);
}
__device__ __forceinline__ void sgu_phase(LAS unsigned char* lds, const bf16* Ub, bf16* Ob, const bf16* Vb, const bf16* Gb, const float* vss, const bf16* Wm, const float* vgain, const float* bs, int vcu, int G, int wave_s) {
    int tid_l = my_tid(wave_s); const int tid = tid_l, lane = tid & 63, r32 = lane & 31, hi = lane >> 5;
    const int wid = __builtin_amdgcn_readfirstlane(tid >> 6), tbk = wid & 3, cw = wid >> 2;
    LAS float* rs = (LAS float*)lds; LAS unsigned char* vT = lds + 512;
    LAS float* yl = (LAS float*)(lds + 36864);
    SguV N;
    if (vcu < 2048) sgu_issue_v(N, Vb, vss, Wm, (vcu >> 4) * 128, vcu & 15, tid);
#pragma unroll 1
    for (int u = vcu; u < 2048; u += G) {
        const int row0 = (u >> 4) * 128, g = u & 15;
        SguV C = N;
        u32x4 uv[4]; float gn[2], bsv[16];
#pragma unroll
        for (int i = 0; i < 4; ++i) { const int p = tid + 512 * i, row = p >> 4, ck = p & 15; const size_t off = (size_t)(row0 + row) * BR + g * 128 + ck * 8;
            uv[i] = *(const u32x4*)(Ub + off); }
#pragma unroll
        for (int b = 0; b < 2; ++b) gn[b] = vgain[g * 128 + 64 * cw + 32 * b + r32];
#pragma unroll
        for (int r = 0; r < 16; ++r) bsv[r] = bs[g * 128 + 32 * tbk + crow(r, hi)];
        if (tid < 128) { float s = 0.f;
#pragma unroll
            for (int i = 0; i < 8; ++i) s += (C.vq[i][0] + C.vq[i][1]) + (C.vq[i][2] + C.vq[i][3]);
            rs[tid] = 1.0f / sqrtf(s * (1.0f / 2048.0f) + 1e-6f); }
        __syncthreads();
#pragma unroll
        for (int i = 0; i < 2; ++i) { const int p = tid + 512 * i, sp = p & 63, chk = p >> 6, s = 2 * sp;
            const float ra = rs[s], rb = rs[s + 1];
#pragma unroll
            for (int e = 0; e < 4; ++e) { const float a0 = __uint_as_float(C.va[i][e] << 16) * ra, a1 = __uint_as_float(C.va[i][e] & 0xffff0000u) * ra, b0 = __uint_as_float(C.vb2[i][e] << 16) * rb, b1 = __uint_as_float(C.vb2[i][e] & 0xffff0000u) * rb;
                *(LAS unsigned*)(vT + (chk * 8 + 2 * e) * 272 + s * 2) = pk2(a0, b0); *(LAS unsigned*)(vT + (chk * 8 + 2 * e + 1) * 272 + s * 2) = pk2(a1, b1); } }
        __syncthreads();
        f32x16 acc[2];
#pragma unroll
        for (int b = 0; b < 2; ++b)
#pragma unroll
            for (int r = 0; r < 16; ++r) acc[b][r] = 0.f;
        const LAS unsigned char* vbp = vT + (64 * cw + r32) * 272 + hi * 16;
#pragma unroll
        for (int c = 0; c < 8; ++c) if (c <= 2 * tbk + 1) {
#pragma unroll
            for (int b = 0; b < 2; ++b) { const bf16x8 bfr = *(const LAS bf16x8*)(vbp + b * 32 * 272 + c * 32); acc[b] = MFMA32(C.af[c], bfr, acc[b]); } }
#pragma unroll
        for (int b = 0; b < 2; ++b) { const int chl = 64 * cw + 32 * b + r32;
#pragma unroll
            for (int r = 0; r < 16; ++r) { const int t = 32 * tbk + crow(r, hi); yl[t * 132 + chl] = acc[b][r] * gn[b] + bsv[r]; } }
        if (u + G < 2048) sgu_issue_v(N, Vb, vss, Wm, ((u + G) >> 4) * 128, (u + G) & 15, tid);
        __syncthreads();
#pragma unroll
        for (int i = 0; i < 4; ++i) { const int p = tid + 512 * i, row = p >> 4, ck = p & 15; const size_t off = (size_t)(row0 + row) * BR + g * 128 + ck * 8;
            const f32x4 y0 = *(const LAS f32x4*)(yl + row * 132 + ck * 8), y1 = *(const LAS f32x4*)(yl + row * 132 + ck * 8 + 4); u32x4 w;
#pragma unroll
            for (int e = 0; e < 4; ++e) { const float u0 = __uint_as_float(uv[i][e] << 16), u1 = __uint_as_float(uv[i][e] & 0xffff0000u);
                const float ya = e < 2 ? y0[2 * e] : y1[2 * e - 4], yb = e < 2 ? y0[2 * e + 1] : y1[2 * e - 3];
                w[e] = pk2(ya * u0, yb * u1); }
            *(u32x4*)(Ob + off) = w; }
        asm volatile("s_waitcnt lgkmcnt(0)" ::: "memory"); __builtin_amdgcn_s_barrier(); asm volatile("" ::: "memory");
    }
}
#define XB_TMO      128
#define XB_XCNT(j)  (256  + 64 * (j))
#define XB_XSUB(j)  (1280 + 64 * (j))
#define XB_XGEN(j)  (2304 + 64 * (j))
#define XB_TOP      3328
#define XB_TOPGEN   3392
#define XCD_BAR_WORDS 3456
#define XB_SPIN_CAP (1u << 18)

__device__ __forceinline__ unsigned xb_ld(unsigned* p)              { return __hip_atomic_load(p, __ATOMIC_RELAXED, __HIP_MEMORY_SCOPE_AGENT); }
__device__ __forceinline__ unsigned xb_add(unsigned* p, unsigned v) { return __hip_atomic_fetch_add(p, v, __ATOMIC_RELAXED, __HIP_MEMORY_SCOPE_AGENT); }
__device__ __forceinline__ unsigned xb_xcc_id() { return (unsigned)__builtin_amdgcn_s_getreg((3 << 11) | 20) & 0xFu; }
#define XB_SPIN(cond, bar) do { unsigned _sp = 0; while (cond) { __builtin_amdgcn_s_sleep(1); \
    if ((++_sp & 255u) == 0u) { if (xb_ld(&(bar)[XB_TMO])) break; if (_sp > XB_SPIN_CAP) { atomicAdd(&(bar)[XB_TMO], 1u); break; } } } } while (0)

struct XcdBarrier {
    unsigned* bar; unsigned x;
    volatile LAS unsigned* st;
};

__device__ __forceinline__ XcdBarrier xcd_barrier_post(unsigned* bar, volatile LAS unsigned* st, int tid_) {
    XcdBarrier b; b.bar = bar; b.x = xb_xcc_id(); b.st = st;
    if (tid_ == 0) (void)xb_add(&bar[XB_XCNT(b.x)], 1u);
    return b;
}
__device__ __forceinline__ void xcd_barrier_complete(unsigned* bar, unsigned x, unsigned& nloc, unsigned& nx) {
    const unsigned G = gridDim.x * gridDim.y * gridDim.z;
    unsigned sum, cnt, mine, sp = 0u;
    for (;;) {
        sum = 0u; cnt = 0u; mine = 0u;
#pragma unroll
        for (unsigned j = 0; j < 16; ++j) { const unsigned c = xb_ld(&bar[XB_XCNT(j)]); sum += c; cnt += (c > 0u) ? 1u : 0u; mine = (j == x) ? c : mine; }
        if (sum == G) break;
        __builtin_amdgcn_s_sleep(1);
        if ((++sp & 255u) == 0u) { if (xb_ld(&bar[XB_TMO])) break; if (sp > XB_SPIN_CAP) { atomicAdd(&bar[XB_TMO], 1u); break; } }
    }
    nloc = mine > 0u ? mine : 1u; nx = cnt > 0u ? cnt : 1u;
}

__device__ __forceinline__ void xcd_barrier(const XcdBarrier& b, int tid_) {
    asm volatile("s_waitcnt vmcnt(0)" ::: "memory");
    __syncthreads();
    if (tid_ == 0) {
        unsigned* bar = b.bar;
        __builtin_amdgcn_s_waitcnt(0);
        unsigned nloc = b.st[0], nx = b.st[1];
        if (nloc == 0u) { xcd_barrier_complete(bar, b.x, nloc, nx); b.st[0] = nloc; b.st[1] = nx; }
        const unsigned old = xb_add(&bar[XB_XSUB(b.x)], 1u);
        const unsigned gen = old / nloc;
        if (old + 1u == (gen + 1u) * nloc) {
            __builtin_amdgcn_fence(__ATOMIC_RELEASE, "agent");
            asm volatile("s_waitcnt vmcnt(0)" ::: "memory");
            const unsigned og = xb_add(&bar[XB_TOP], 1u);
            const unsigned tg = og / nx;
            if (og + 1u == (tg + 1u) * nx) xb_add(&bar[XB_TOPGEN], 1u);
            else XB_SPIN(xb_ld(&bar[XB_TOPGEN]) == tg, bar);
            __builtin_amdgcn_fence(__ATOMIC_ACQUIRE, "agent");
            xb_add(&bar[XB_XGEN(b.x)], 1u);
            asm volatile("s_waitcnt vmcnt(0)" ::: "memory");
        } else {
            XB_SPIN(xb_ld(&bar[XB_XGEN(b.x)]) == gen, bar);
            __builtin_amdgcn_fence(__ATOMIC_ACQUIRE, "agent");
            asm volatile("s_waitcnt vmcnt(0)" ::: "memory");
        }
    }
    __syncthreads();
}
__global__ void __launch_bounds__(512, 2) mega_fwd(Args a) {
    extern __shared__ __attribute__((aligned(16))) unsigned char lds_raw[];
    LAS unsigned char* lds = (LAS unsigned char*)lds_raw;
    cg::grid_group grid = cg::this_grid();
    volatile LAS unsigned* MISC = (volatile LAS unsigned*)(lds + RING_BYTES + 320);
    const int wave_s = __builtin_amdgcn_readfirstlane(threadIdx.x >> 6);
    { const int t0 = my_tid(wave_s); if (t0 < 32) MISC[t0] = 0u; }
    __syncthreads();
    XcdBarrier bar = xcd_barrier_post((unsigned*)a.ws, MISC + 8, my_tid(wave_s));
    const int G = gridDim.x, bx = blockIdx.x, vcu = (G % 8 == 0) ? (bx % 8) * (G / 8) + bx / 8 : bx;
    unsigned char* ws = a.ws;
    bf16* xb = (bf16*)(ws + WS_XB); float* rowss = (float*)(ws + WS_ROWSS); float* vss = (float*)(ws + WS_VSS);
    bf16* act = (bf16*)(ws + WS_ACT); bf16* wbase = (bf16*)(ws + WS_W);
    bf16* ybuf = (bf16*)(ws + WS_END);
    for (int ph = a.ph_lo; ph < a.ph_hi; ++ph) {
        int tid_l = my_tid(wave_s); const int tid = tid_l, lane = tid & 63, wave = __builtin_amdgcn_readfirstlane(tid >> 6);
        if (ph == 0) prologue(a, lds, vcu, G, wave_s);
        else if (ph == NPHASE - 1) {
            const float* gf = a.in[16];
            for (int m = vcu * 8 + wave; m < MTOK; m += G * 8) { const u32x2* xr = (const u32x2*)(xb + (size_t)m * DM) + lane; f32x4 v[4]; float s = 0.f;
#pragma unroll
                for (int j = 0; j < 4; ++j) { const u32x2 w = xr[64 * j]; v[j][0] = __uint_as_float(w.x << 16); v[j][1] = __uint_as_float(w.x & 0xffff0000u); v[j][2] = __uint_as_float(w.y << 16); v[j][3] = __uint_as_float(w.y & 0xffff0000u);
                    s += (v[j][0] * v[j][0] + v[j][1] * v[j][1]) + (v[j][2] * v[j][2] + v[j][3] * v[j][3]); }
                const float rstd = 1.0f / sqrtf(wave_sum(s) * (1.0f / DM) + 1e-6f);
                f32x4* orow = (f32x4*)(a.out + (size_t)m * DM) + lane;
#pragma unroll
                for (int j = 0; j < 4; ++j) { const f32x4 gg = *((const f32x4*)gf + lane + 64 * j); orow[64 * j] = v[j] * rstd * gg; } }
        } else {
            const int q8p = (ph - 2) >> 1; const bool odd = (ph & 1) != 0;
            const int nsub = (ph > 1 && odd && q8p < 7) ? 2 : 1;
            for (int sub = 0; sub < nsub; ++sub) {
            const int st = (ph == 1) ? 0 : (!odd ? 1 : (sub == 0 ? 2 : 0));
            const int q8 = (ph == 1) ? 0 : q8p + (sub == 1 ? 1 : 0);
            const int L = q8 >> 1, hb = q8 & 1, j = L >> 1; const bool is_attn = (L & 1) == 0;
            const bf16* xbh = xb + (size_t)hb * HTOK * DM; const float* rssh = (const float*)(ws + WS_RSTD) + (size_t)hb * HTOK;
            if (st == 0) {
                const bf16* wt = is_attn ? wbase + (W_ATT_IN + (size_t)j * 16 * MiB) / 2 : wbase + (W_SGU_IN + (size_t)j * 12 * MiB) / 2;
                { pg8::Gemm g{xbh, wt, HTOK, 6144, DM}; pg8::StaticOrder S; S.init(HTOK, 6144, G, bx);
                  pg8::EpiIn E{act, BR, BR, ACT_STRIDE, QSCALE, is_attn ? 8 : 0, rssh, vss, is_attn ? 0 : 16, is_attn ? 0 : 24, is_attn ? 0 : 16};
                  pg8::gemm_phase<pg8::EpiIn, pg8::StaticOrder, true, true>(lds, g, S, E, wave_s); }
                if (is_attn) { pg8::Gemm g{wt + (size_t)6144 * DM, xbh, BR, HTOK, DM}; pg8::StaticOrder S; S.init(BR, HTOK, G, bx);
                  pg8::EpiVT E{act + 3 * ACT_STRIDE, HTOK, rssh};
                  pg8::gemm_phase<pg8::EpiVT, pg8::StaticOrder, true, true>(lds, g, S, E, wave_s); }
            } else if (st == 1) {
                if ((hb == 1 || L > 0) && tid < 64) {
                    for (int r_ = bx * 64 + tid; r_ < HTOK; r_ += G * 64) { const int row = (1 - hb) * HTOK + r_; ((float*)(ws + WS_RSTD))[row] = pg8::rstd16(rowss + (size_t)row * 16); } }
                if (is_attn) {
                    const float lam_init = (L == 0) ? 0.2f : 0.47071302f;
                    const float d1 = wave_sum(a.in[4][j * 64 + lane] * a.in[5][j * 64 + lane]), d2 = wave_sum(a.in[6][j * 64 + lane] * a.in[7][j * 64 + lane]);
                    const float lam = expf(d1) - expf(d2) + lam_init;
                    if (PROBE_DUP == 1) { bf16* yb2 = ybuf;
                      for (int p = vcu; p < 1024; p += G) { const int bh = p >> 4, s = p & 15;
                        attn_unit<PROBE_ABL>(lds, act, yb2, act + ACT_STRIDE, act + 2 * ACT_STRIDE, act + 3 * ACT_STRIDE, a.in[1], a.in[8] + j * 128, lam, 1.0f - lam_init, bh >> 4, bh & 15, 31 - s, wave_s);
                        attn_unit<PROBE_ABL>(lds, act, yb2, act + ACT_STRIDE, act + 2 * ACT_STRIDE, act + 3 * ACT_STRIDE, a.in[1], a.in[8] + j * 128, lam, 1.0f - lam_init, bh >> 4, bh & 15, s, wave_s); } }
                    for (int p = vcu; p < 1024; p += G) { const int bh = p >> 4, s = p & 15;
                        attn_unit<0>(lds, act, ybuf, act + ACT_STRIDE, act + 2 * ACT_STRIDE, act + 3 * ACT_STRIDE, a.in[1], a.in[8] + j * 128, lam, 1.0f - lam_init, bh >> 4, bh & 15, 31 - s, wave_s);
                        attn_unit<0>(lds, act, ybuf, act + ACT_STRIDE, act + 2 * ACT_STRIDE, act + 3 * ACT_STRIDE, a.in[1], a.in[8] + j * 128, lam, 1.0f - lam_init, bh >> 4, bh & 15, s, wave_s); }
                } else {
                    const bf16* wm = (const bf16*)(ws + WS_WM) + (size_t)j * 16 * 128 * 128;
                    sgu_phase(lds, act, ybuf, act + ACT_STRIDE, act + 2 * ACT_STRIDE, vss, wm, a.in[12] + j * BR, a.in[14] + j * 16 * 128, vcu, G, wave_s);
                }
            } else {
                const bf16* wt = is_attn ? wbase + (W_ATT_OUT + (size_t)j * 4 * MiB) / 2 : wbase + (W_SGU_OUT + (size_t)j * 4 * MiB) / 2;
                pg8::Gemm g{ybuf, wt, HTOK, DM, BR}; pg8::StaticOrder S; S.init(HTOK, DM, G, bx);
                pg8::EpiOut E{L == 0 ? a.in[0] : nullptr, xb, rowss, hb * HTOK};
                pg8::gemm_phase<pg8::EpiOut, pg8::StaticOrder, true, true>(lds, g, S, E, wave_s);
            }
            }
        }
        if (ph + 1 < a.ph_hi) { if (ph == 0 && a.pad0 != 0) grid.sync(); else xcd_barrier(bar, my_tid(wave_s)); }
    }
}

extern "C" void kernel_launch(void* const* d_in, const int* in_sizes, int n_in, void* d_out, int out_size, void* d_ws, size_t ws_size, hipStream_t stream) {
    static int grid = 0;
    if (grid == 0) {
        if (n_in != 17 || out_size != MTOK * DM || ws_size < WS_END + 64 * MiB) { fprintf(stderr, "kernel_launch: unexpected shapes: n_in %d out %d ws %zu\n", n_in, out_size, ws_size); grid = -1; return; }
        int dev = 0, cus = 0, per_cu = 0;
        hipGetDevice(&dev); hipDeviceGetAttribute(&cus, hipDeviceAttributeMultiprocessorCount, dev);
        if (hipFuncSetAttribute((const void*)mega_fwd, hipFuncAttributeMaxDynamicSharedMemorySize, LDS_BYTES) != hipSuccess) { fprintf(stderr, "kernel_launch: hipFuncSetAttribute failed\n"); grid = -1; return; }
        if (hipOccupancyMaxActiveBlocksPerMultiprocessor(&per_cu, (const void*)mega_fwd, 512, LDS_BYTES) != hipSuccess || per_cu < 1) { fprintf(stderr, "kernel_launch: occupancy query gives %d\n", per_cu); per_cu = 1; }
        (void)hipGetLastError();
        grid = cus * per_cu; if (grid > 256) grid = 256;
        fprintf(stderr, "kernel_launch: grid %d (cus %d per_cu %d) ws %zu\n", grid, cus, per_cu, ws_size);
    }
    if (grid < 0) return;
    if (hipMemsetAsync(d_ws, 0, 65536, stream) != hipSuccess) { fprintf(stderr, "kernel_launch: memset failed\n"); return; }
    Args a{};
    for (int i = 0; i < 17; ++i) a.in[i] = (const float*)d_in[i];
    a.out = (float*)d_out; a.ws = (unsigned char*)d_ws;
#if ONE_LAUNCH
    a.ph_lo = 0; a.ph_hi = NPHASE;
    void* kargs[] = {&a};
    hipError_t e = hipLaunchCooperativeKernel((const void*)mega_fwd, dim3(grid), dim3(512), kargs, LDS_BYTES, stream);
    if (e != hipSuccess) fprintf(stderr, "kernel_launch: cooperative launch failed: %s (grid %d)\n", hipGetErrorString(e), grid);
#else
    for (int ph = 0; ph < NPHASE; ++ph) { a.ph_lo = ph; a.ph_hi = ph + 1; hipLaunchKernelGGL(mega_fwd, dim3(grid), dim3(512), LDS_BYTES, stream, a); }
#endif
}
```
